# Optimizing an MI355X kernel written in HIP

```python
import math
import jax, jax.numpy as jnp
from jax import lax
import numpy as np

D_MODEL = 1024
BATCH = 8
SEQ = 4096
DEPTH = 4

N_HYB = (DEPTH + 1) // 2
N_REC = DEPTH // 2
NORM_EPS = 1e-6
CONV_K = 4
D_FF = 2816
D_SSM = D_MODEL
SSM_HEAD_DIM = 64
SSM_HEADS = D_SSM // SSM_HEAD_DIM
SSM_GROUPS = 2
SSM_STATE = 128
SSM_CONV_DIM = D_SSM + 2 * SSM_GROUPS * SSM_STATE
SSD_CHUNK = 128
FOX_HEAD_DIM = 128
FOX_HEADS = 8
D_FOX = FOX_HEADS * FOX_HEAD_DIM
Q_BLOCK = 128
HYB_IN = D_SSM + SSM_CONV_DIM + SSM_HEADS + 3 * D_FOX + FOX_HEADS
D_RNN = D_MODEL
RNN_BLOCKS = 8
RNN_BLOCK = D_RNN // RNN_BLOCKS
RG_LRU_C = 8.0

kernel_name = "hybrid_ssd_fox_rglru_macaron_sandwich"


def rms_norm(x, g):
    xf = x.astype(jnp.float32)
    y = xf * lax.rsqrt(jnp.mean(xf * xf, axis=-1, keepdims=True) + NORM_EPS)
    return (y * g.astype(jnp.float32)).astype(x.dtype)


def swiglu(x, w_in, w_out):
    gate, up = jnp.split(x @ w_in, 2, axis=-1)
    return (jax.nn.silu(gate) * up) @ w_out


def causal_conv(x, w, bias):
    s = x.shape[1]
    kw = w.shape[0]
    xp = jnp.pad(x, ((0, 0), (kw - 1, 0), (0, 0)))
    y = xp[:, 0:s] * w[0]
    for k in range(1, kw):
        y = y + xp[:, k:k + s] * w[k]
    return y + bias


def ssd_chunked(xh, dt, a, bm, cm):
    b, s, nh, p = xh.shape
    g, n = bm.shape[-2:]
    kh = nh // g
    c = s // SSD_CHUNK
    X = (xh.astype(jnp.float32) * dt[..., None]).reshape(b, c, SSD_CHUNK, g, kh, p)
    Bc = bm.astype(jnp.float32).reshape(b, c, SSD_CHUNK, g, n)
    Cc = cm.astype(jnp.float32).reshape(b, c, SSD_CHUNK, g, n)
    dA = (dt * a).reshape(b, c, SSD_CHUNK, g, kh).transpose(0, 3, 4, 1, 2)
    a_cs = jnp.cumsum(dA, axis=-1)
    causal = jnp.tril(jnp.ones((SSD_CHUNK, SSD_CHUNK), dtype=bool))
    seg = a_cs[..., :, None] - a_cs[..., None, :]
    L = jnp.exp(jnp.where(causal, seg, -jnp.inf))
    cb = jnp.einsum("bclgn,bcsgn->bgcls", Cc, Bc)
    y_diag = jnp.einsum("bgkcls,bcsgkp->bclgkp", L * cb[:, :, None], X)
    decay_states = jnp.exp(a_cs[..., -1:] - a_cs)
    states = jnp.einsum("bclgn,bgkcl,bclgkp->bcgkpn", Bc, decay_states, X)
    chunk_tot = a_cs[..., -1]
    chunk_cs = jnp.cumsum(chunk_tot, axis=-1)
    cs_prev = chunk_cs - chunk_tot
    seg_c = cs_prev[..., :, None] - chunk_cs[..., None, :]
    strict = jnp.tril(jnp.ones((c, c), dtype=bool), k=-1)
    decay_chunk = jnp.exp(jnp.where(strict, seg_c, -jnp.inf))
    init_states = jnp.einsum("bgkzc,bcgkpn->bzgkpn", decay_chunk, states)
    state_decay_out = jnp.exp(a_cs)
    y_off = jnp.einsum("bclgn,bcgkpn,bgkcl->bclgkp", Cc, init_states, state_decay_out)
    return (y_diag + y_off).reshape(b, s, nh, p)


def forgetting_attention(q, k, v, log_f):
    b, s, h, d = q.shape
    nblk = s // Q_BLOCK
    cum = jnp.cumsum(log_f, axis=1).transpose(0, 2, 1)
    qb = q.reshape(b, nblk, Q_BLOCK, h, d).transpose(1, 0, 2, 3, 4)
    cqb = cum.reshape(b, h, nblk, Q_BLOCK).transpose(2, 0, 1, 3)
    kpos = jnp.arange(s)
    scale = d ** -0.5

    def block(args):
        qi, ci, i = args
        logits = jnp.einsum("bqhd,bkhd->bhqk", qi, k).astype(jnp.float32) * scale
        logits = logits + ci[..., :, None] - cum[:, :, None, :]
        qpos = i * Q_BLOCK + jnp.arange(Q_BLOCK)
        mask = kpos[None, :] <= qpos[:, None]
        probs = jax.nn.softmax(jnp.where(mask, logits, -jnp.inf), axis=-1)
        return jnp.einsum("bhqk,bkhd->bqhd", probs.astype(v.dtype), v)

    out = lax.map(block, (qb, cqb, jnp.arange(nblk)))
    return out.transpose(1, 0, 2, 3, 4).reshape(b, s, h, d)


def hybrid_mixer(h, w_in, conv_w, conv_b, dt_bias, a_log, d_skip, ssm_norm_g, fox_b_f, w_out):
    b, s, _ = h.shape
    sizes = (D_SSM, SSM_CONV_DIM, SSM_HEADS, D_FOX, D_FOX, D_FOX)
    offs = np.cumsum(sizes).tolist()
    z, xbc, dt_raw, q, k, v, f_raw = jnp.split(h @ w_in, offs, axis=-1)
    xbc = jax.nn.silu(causal_conv(xbc, conv_w, conv_b))
    xs, bm, cm = jnp.split(xbc, [D_SSM, D_SSM + SSM_GROUPS * SSM_STATE], axis=-1)
    xh = xs.reshape(b, s, SSM_HEADS, SSM_HEAD_DIM)
    dt = jax.nn.softplus(dt_raw.astype(jnp.float32) + dt_bias.astype(jnp.float32))
    a = -jnp.exp(a_log.astype(jnp.float32))
    y = ssd_chunked(xh, dt, a,
                    bm.reshape(b, s, SSM_GROUPS, SSM_STATE),
                    cm.reshape(b, s, SSM_GROUPS, SSM_STATE))
    y = y + d_skip.astype(jnp.float32)[:, None] * xh.astype(jnp.float32)
    y = y.reshape(b, s, D_SSM) * jax.nn.silu(z.astype(jnp.float32))
    yg = y.reshape(b, s, SSM_GROUPS, D_SSM // SSM_GROUPS)
    yg = yg * lax.rsqrt(jnp.mean(yg * yg, axis=-1, keepdims=True) + NORM_EPS)
    y_ssm = (yg.reshape(b, s, D_SSM) * ssm_norm_g.astype(jnp.float32)).astype(h.dtype)
    log_f = jax.nn.log_sigmoid(f_raw.astype(jnp.float32) + fox_b_f.astype(jnp.float32))
    o = forgetting_attention(q.reshape(b, s, FOX_HEADS, FOX_HEAD_DIM),
                             k.reshape(b, s, FOX_HEADS, FOX_HEAD_DIM),
                             v.reshape(b, s, FOX_HEADS, FOX_HEAD_DIM), log_f)
    o = o.reshape(b, s, D_FOX).astype(h.dtype)
    return jnp.concatenate([y_ssm, o], axis=-1) @ w_out


def rg_lru(x, w_a, b_a, w_x, b_x, lam):
    b, s, d = x.shape
    xb = x.reshape(b, s, RNN_BLOCKS, RNN_BLOCK)
    r = jax.nn.sigmoid((jnp.einsum("bsnj,njk->bsnk", xb, w_a).reshape(b, s, d) + b_a).astype(jnp.float32))
    i = jax.nn.sigmoid((jnp.einsum("bsnj,njk->bsnk", xb, w_x).reshape(b, s, d) + b_x).astype(jnp.float32))
    log_a = RG_LRU_C * r * jax.nn.log_sigmoid(lam.astype(jnp.float32))
    a = jnp.exp(log_a)
    u = jnp.sqrt(-jnp.expm1(2.0 * log_a)) * (i * x.astype(jnp.float32))

    def combine(left, right):
        a1, b1 = left
        a2, b2 = right
        return a1 * a2, a2 * b1 + b2

    _, hs = lax.associative_scan(combine, (a, u), axis=1)
    return hs.astype(x.dtype)


def recurrent_mixer(h, w_in, conv_w, conv_b, w_a, b_a, w_x, b_x, lam, w_out):
    gate, xr = jnp.split(h @ w_in, 2, axis=-1)
    gate = jax.nn.gelu(gate, approximate=True)
    xr = causal_conv(xr, conv_w, conv_b)
    return (rg_lru(xr, w_a, b_a, w_x, b_x, lam) * gate) @ w_out


def setup_inputs(seed: int = 0) -> dict:
    key = jax.random.key(seed)
    ks = jax.random.split(key, 24)
    f32 = jnp.float32

    def nrm(k, shape, scale):
        return jax.random.normal(k, shape, f32) * scale

    def unif(k, shape, lo, hi):
        return jax.random.uniform(k, shape, f32, lo, hi)

    x = nrm(ks[0], (BATCH, SEQ, D_MODEL), 1.0)
    norm_g = 1.0 + nrm(ks[1], (DEPTH, 6, D_MODEL), 0.05)
    ffn_w_in = nrm(ks[2], (DEPTH, 2, D_MODEL, 2 * D_FF), D_MODEL ** -0.5)
    ffn_w_out = nrm(ks[3], (DEPTH, 2, D_FF, D_MODEL), D_FF ** -0.5)
    hyb_w_in = nrm(ks[4], (N_HYB, D_MODEL, HYB_IN), D_MODEL ** -0.5)
    ssm_conv_w = nrm(ks[5], (N_HYB, CONV_K, SSM_CONV_DIM), CONV_K ** -0.5)
    ssm_conv_b = nrm(ks[6], (N_HYB, SSM_CONV_DIM), 0.02)
    dt0 = jnp.exp(unif(ks[7], (N_HYB, SSM_HEADS), math.log(1e-3), math.log(1e-1)))
    ssm_dt_bias = dt0 + jnp.log(-jnp.expm1(-dt0))
    ssm_a_log = jnp.log(unif(ks[8], (N_HYB, SSM_HEADS), 1.0, 16.0))
    ssm_d = 1.0 + nrm(ks[9], (N_HYB, SSM_HEADS), 0.1)
    ssm_norm_g = 1.0 + nrm(ks[10], (N_HYB, D_SSM), 0.05)
    fox_b_f = unif(ks[11], (N_HYB, FOX_HEADS), 1.0, 4.0)
    hyb_w_out = nrm(ks[12], (N_HYB, D_SSM + D_FOX, D_MODEL), (D_SSM + D_FOX) ** -0.5)
    rec_w_in = nrm(ks[13], (N_REC, D_MODEL, 2 * D_RNN), D_MODEL ** -0.5)
    rec_conv_w = nrm(ks[14], (N_REC, CONV_K, D_RNN), CONV_K ** -0.5)
    rec_conv_b = nrm(ks[15], (N_REC, D_RNN), 0.02)
    rec_w_a = nrm(ks[16], (N_REC, RNN_BLOCKS, RNN_BLOCK, RNN_BLOCK), RNN_BLOCK ** -0.5)
    rec_b_a = nrm(ks[17], (N_REC, D_RNN), 0.02)
    rec_w_x = nrm(ks[18], (N_REC, RNN_BLOCKS, RNN_BLOCK, RNN_BLOCK), RNN_BLOCK ** -0.5)
    rec_b_x = nrm(ks[19], (N_REC, D_RNN), 0.02)
    a0 = unif(ks[20], (N_REC, D_RNN), 0.9, 0.999)
    s0 = a0 ** (1.0 / RG_LRU_C)
    rec_lambda = jnp.log(s0) - jnp.log1p(-s0)
    rec_w_out = nrm(ks[21], (N_REC, D_RNN, D_MODEL), D_RNN ** -0.5)
    return {"x": x, "norm_g": norm_g, "ffn_w_in": ffn_w_in, "ffn_w_out": ffn_w_out,
            "hyb_w_in": hyb_w_in, "ssm_conv_w": ssm_conv_w, "ssm_conv_b": ssm_conv_b,
            "ssm_dt_bias": ssm_dt_bias, "ssm_a_log": ssm_a_log, "ssm_d": ssm_d,
            "ssm_norm_g": ssm_norm_g, "fox_b_f": fox_b_f, "hyb_w_out": hyb_w_out,
            "rec_w_in": rec_w_in, "rec_conv_w": rec_conv_w, "rec_conv_b": rec_conv_b,
            "rec_w_a": rec_w_a, "rec_b_a": rec_b_a, "rec_w_x": rec_w_x, "rec_b_x": rec_b_x,
            "rec_lambda": rec_lambda, "rec_w_out": rec_w_out}


def reference(x, norm_g, ffn_w_in, ffn_w_out, hyb_w_in, ssm_conv_w, ssm_conv_b, ssm_dt_bias,
              ssm_a_log, ssm_d, ssm_norm_g, fox_b_f, hyb_w_out, rec_w_in, rec_conv_w, rec_conv_b,
              rec_w_a, rec_b_a, rec_w_x, rec_b_x, rec_lambda, rec_w_out):
    for layer in range(DEPTH):
        g = norm_g[layer]
        h = swiglu(rms_norm(x, g[0]), ffn_w_in[layer, 0], ffn_w_out[layer, 0])
        x = x + 0.5 * rms_norm(h, g[1])
        h = rms_norm(x, g[2])
        if layer % 2 == 0:
            i = layer // 2
            h = hybrid_mixer(h, hyb_w_in[i], ssm_conv_w[i], ssm_conv_b[i], ssm_dt_bias[i],
                             ssm_a_log[i], ssm_d[i], ssm_norm_g[i], fox_b_f[i], hyb_w_out[i])
        else:
            j = layer // 2
            h = recurrent_mixer(h, rec_w_in[j], rec_conv_w[j], rec_conv_b[j], rec_w_a[j], rec_b_a[j],
                                rec_w_x[j], rec_b_x[j], rec_lambda[j], rec_w_out[j])
        x = x + rms_norm(h, g[3])
        h = swiglu(rms_norm(x, g[4]), ffn_w_in[layer, 1], ffn_w_out[layer, 1])
        x = x + 0.5 * rms_norm(h, g[5])
    return x
```

```cpp
#include <hip/hip_runtime.h>
#include <hip/hip_bf16.h>
#include <hip/hip_cooperative_groups.h>
#include <cstdio>
#include <cstdint>
namespace cg = cooperative_groups;
#ifndef PER_PHASE_LAUNCH
#define PER_PHASE_LAUNCH 1
#endif
__device__ __forceinline__ int tidx() { int t = threadIdx.x; asm volatile("" : "+v"(t)); return t; }
__device__ __forceinline__ int bidx() { int t = blockIdx.x; asm volatile("" : "+s"(t)); return t; }
namespace pg8 {
#define PG8_LAS __attribute__((address_space(3)))
typedef unsigned short bf16_t;
typedef short bf16x8 __attribute__((ext_vector_type(8)));
typedef float f32x4 __attribute__((ext_vector_type(4)));
typedef unsigned u32x4 __attribute__((ext_vector_type(4)));
constexpr int BM = 256, BK = 64, HALF = 128, HTB = HALF * BK * 2  , STAGE_BYTES = 8 * HTB, NXCD = 8, WGM = 8;

__host__ __device__ __forceinline__ int lds_byte(int r, int c) { const int st = (r >> 4) * 2 + (c >> 5), rr = r & 15, cc = c & 31, ob = rr * 64 + cc * 2; return st * 1024 + (ob ^ (((ob >> 9) & 1) << 5)); }
__host__ __device__ __forceinline__ void stage_rc(int b, int& R, int& C) { const int st = b / 1024, sb = b % 1024, swz = sb ^ (((sb >> 9) & 1) << 5); R = (st >> 1) * 16 + swz / 64; C = (st & 1) * 32 + (swz % 64) / 2; }
__host__ __device__ __forceinline__ int perm32(int rho) { const int n = rho >> 4, i = rho & 15; return 8 * (i >> 2) + 4 * n + (i & 3); }

struct Unit { int pm, pn; };
struct Gemm { const bf16_t* A; const bf16_t* Bt; int M, N, K; };

struct StaticOrder {
    int nM, nN, nwg, G, c;
    __host__ __device__ void init(int M, int N, int G_, int c_) { nM = M / BM; nN = N / BM; nwg = nM * nN; G = G_; c = c_; }
    __host__ __device__ bool next(int i, Unit& u) const {
        const long L = (long)i * G + c; if (L >= nwg) return false;
        int wgid = (int)L; { const int q = nwg / NXCD, r = nwg % NXCD, xcd = wgid % NXCD, off = wgid / NXCD; wgid = (xcd < r ? xcd * (q + 1) : r * (q + 1) + (xcd - r) * q) + off; }
        const int nig = WGM * nN, gid = wgid / nig, fm = gid * WGM, gsz = (nM - fm) < WGM ? (nM - fm) : WGM;
        u.pm = fm + ((wgid % nig) % gsz); u.pn = (wgid % nig) / gsz; return true;
    }
    __device__ __forceinline__ void a_ready(const Unit&) const {}
    __device__ __forceinline__ void done(const Unit&) const {}
};
__device__ __forceinline__ unsigned cvt_pk_bf16(float lo, float hi) { unsigned r; asm volatile("v_cvt_pk_bf16_f32 %0, %1, %2" : "=v"(r) : "v"(lo), "v"(hi)); return r; }

template <class Epi, class Sched, bool STAMP = false>
__device__ __forceinline__ void gemm_phase(PG8_LAS unsigned char* lds, const Gemm g, const Sched& S, const Epi& E, unsigned long long* stamps) {
    const int tid = tidx(), wid = __builtin_amdgcn_readfirstlane(tid >> 6), lane = tid & 63, wr = wid >> 2, wc = wid & 3, fr = lane & 15, fq = lane >> 4;
    const int K = g.K, nt = K / BK;
    int ts_lo = 0, ts_hi = 0, nts = 0; const unsigned long long rt_entry = STAMP ? (unsigned long long)wall_clock64() : 0ull;
#define PG8_STAMP() do { if (STAMP && wid == 0 && nts < 64) { const unsigned long long _c = (unsigned long long)clock64(); \
        ts_lo = (lane == nts) ? (int)(unsigned)_c : ts_lo; ts_hi = (lane == nts) ? (int)(unsigned)(_c >> 32) : ts_hi; ++nts; } } while (0)
    PG8_STAMP();
    unsigned voffA[2], voffB[2];
#pragma unroll
    for (int i = 0; i < 2; ++i) { int R, C; stage_rc(tid * 16 + i * 8192, R, C); const int Rb = Epi::PERM ? ((R & ~31) + perm32(R & 31)) : R;
        voffA[i] = (unsigned)(R * K + C) * 2u; voffB[i] = (unsigned)(Rb * K + C) * 2u; }
    const size_t kstep = (size_t)(BK * 2);
    const size_t hstep = (size_t)HALF * K * 2;
    const size_t tstep = 2 * hstep;
    const unsigned ldsw = (unsigned)wid * 1024u;
    const int aoff = lds_byte(wr * 64 + fr, fq * 8), boff = lds_byte(wc * 32 + fr, fq * 8);
#define PG8_SA(b, h) (((b) * 2 + (h)) * HTB)
#define PG8_SB(b, h) ((4 + (b) * 2 + (h)) * HTB)
#define PG8_STAGE(bufoff, gbase, voff) do { _Pragma("unroll") for (int _i = 0; _i < 2; ++_i) \
        __builtin_amdgcn_global_load_lds((const unsigned*)((const char*)(gbase) + (voff)[_i]), (PG8_LAS unsigned*)(lds + (bufoff) + ldsw + _i * 8192), 16, 0, 0); } while (0)
#define PG8_LDA(dst, b, h) do { _Pragma("unroll") for (int m = 0; m < 4; ++m) _Pragma("unroll") for (int k = 0; k < 2; ++k) dst[m][k] = *(const PG8_LAS bf16x8*)(lds + PG8_SA(b, h) + aoff + m * 2048 + k * 1024); } while (0)
#define PG8_LDB(dst, b, h) do { _Pragma("unroll") for (int n = 0; n < 2; ++n) _Pragma("unroll") for (int k = 0; k < 2; ++k) dst[n][k] = *(const PG8_LAS bf16x8*)(lds + PG8_SB(b, h) + boff + n * 2048 + k * 1024); } while (0)
#define PG8_MMA(ai, bj, At, Bt) do { __builtin_amdgcn_s_setprio(1); _Pragma("unroll") for (int m = 0; m < 4; ++m) _Pragma("unroll") for (int n = 0; n < 2; ++n) _Pragma("unroll") for (int k = 0; k < 2; ++k) \
        acc[ai][bj][m][n] = __builtin_amdgcn_mfma_f32_16x16x32_bf16(Bt[n][k], At[m][k], acc[ai][bj][m][n], 0, 0, 0); __builtin_amdgcn_s_setprio(0); } while (0)
#define PG8_WAIT_V(n) asm volatile("s_waitcnt vmcnt(" #n ")" ::: "memory")
#define PG8_WAIT_L(n) asm volatile("s_waitcnt lgkmcnt(" #n ")" ::: "memory")
#define PG8_BAR __builtin_amdgcn_s_barrier()
#define PG8_SCHED __builtin_amdgcn_sched_barrier(0)
    Unit cur, nxt; int ui = 0;
    if (!S.next(0, cur)) return;
    f32x4 acc[2][2][4][2];
#pragma unroll
    for (int a = 0; a < 2; ++a)
#pragma unroll
        for (int b = 0; b < 2; ++b)
#pragma unroll
            for (int m = 0; m < 4; ++m)
#pragma unroll
                for (int n = 0; n < 2; ++n) acc[a][b][m][n] = (f32x4){0.f, 0.f, 0.f, 0.f};
    bf16x8 At[4][2], B0[2][2], B1[2][2];
    const char* cA = (const char*)g.A + (size_t)cur.pm * tstep; const char* cB = (const char*)g.Bt + (size_t)cur.pn * tstep;
    S.a_ready(cur);
    PG8_STAGE(PG8_SB(0, 0), cB, voffB); PG8_STAGE(PG8_SA(0, 0), cA, voffA); PG8_STAGE(PG8_SB(0, 1), cB + hstep, voffB); PG8_STAGE(PG8_SA(0, 1), cA + hstep, voffA);
    if (wr == 1) PG8_BAR;
    PG8_WAIT_V(4); PG8_BAR;
    PG8_STAGE(PG8_SB(1, 0), cB + kstep, voffB); PG8_STAGE(PG8_SA(1, 0), cA + kstep, voffA); PG8_STAGE(PG8_SB(1, 1), cB + hstep + kstep, voffB);
    PG8_WAIT_V(6); PG8_BAR;
    PG8_STAMP();
    for (;;) {
        const bool has_next = S.next(ui + 1, nxt);
        const char* nA = has_next ? (const char*)g.A + (size_t)nxt.pm * tstep : cA; const char* nB = has_next ? (const char*)g.Bt + (size_t)nxt.pn * tstep : cB;
        for (int t = 0; t < nt; t += 2) {
            const bool last = (t == nt - 2);
            const char* a1 = cA + (size_t)(t + 1) * kstep;
            const char* a2 = last ? nA : cA + (size_t)(t + 2) * kstep; const char* b2 = last ? nB : cB + (size_t)(t + 2) * kstep;
            const char* a3 = a2 + kstep; const char* b3 = b2 + kstep;
            if (last && has_next) S.a_ready(nxt);
            PG8_LDB(B0, 0, 0); PG8_SCHED; PG8_LDA(At, 0, 0); PG8_STAGE(PG8_SA(1, 1), a1 + hstep, voffA);
            PG8_WAIT_L(8); PG8_BAR; PG8_WAIT_L(0); PG8_MMA(0, 0, At, B0); PG8_BAR; PG8_SCHED;
            PG8_LDB(B1, 0, 1); PG8_STAGE(PG8_SB(0, 0), b2, voffB);
            PG8_BAR; PG8_WAIT_L(0); PG8_MMA(0, 1, At, B1); PG8_BAR;
            PG8_LDA(At, 0, 1); PG8_STAGE(PG8_SA(0, 0), a2, voffA);
            PG8_BAR; PG8_WAIT_L(0); PG8_MMA(1, 0, At, B0); PG8_BAR; PG8_SCHED;
            PG8_STAGE(PG8_SB(0, 1), b2 + hstep, voffB);
            PG8_WAIT_V(6); PG8_BAR; PG8_MMA(1, 1, At, B1); PG8_BAR;
            PG8_LDB(B0, 1, 0); PG8_SCHED; PG8_LDA(At, 1, 0); PG8_STAGE(PG8_SA(0, 1), a2 + hstep, voffA);
            PG8_WAIT_L(8); PG8_BAR; PG8_WAIT_L(0); PG8_MMA(0, 0, At, B0); PG8_BAR; PG8_SCHED;
            PG8_LDB(B1, 1, 1); PG8_STAGE(PG8_SB(1, 0), b3, voffB);
            PG8_BAR; PG8_WAIT_L(0); PG8_MMA(0, 1, At, B1); PG8_BAR;
            PG8_LDA(At, 1, 1); PG8_STAGE(PG8_SA(1, 0), a3, voffA);
            PG8_BAR; PG8_WAIT_L(0); PG8_MMA(1, 0, At, B0); PG8_BAR; PG8_SCHED;
            PG8_STAGE(PG8_SB(1, 1), b3 + hstep, voffB);
            PG8_WAIT_V(6); PG8_BAR; PG8_MMA(1, 1, At, B1); PG8_BAR;
        }
        PG8_STAMP();
        if constexpr (!Epi::AFTER_DRAIN) { E(acc, cur, wr, wc, fr, fq); S.done(cur); }
        PG8_STAMP();
        if (!has_next) break;
#pragma unroll
        for (int a = 0; a < 2; ++a)
#pragma unroll
            for (int b = 0; b < 2; ++b)
#pragma unroll
                for (int m = 0; m < 4; ++m)
#pragma unroll
                    for (int n = 0; n < 2; ++n) acc[a][b][m][n] = (f32x4){0.f, 0.f, 0.f, 0.f};
        cur = nxt; cA = nA; cB = nB; ++ui;
    }
    PG8_WAIT_V(0);
    if (wr == 0) PG8_BAR;
    PG8_BAR;
    if constexpr (Epi::AFTER_DRAIN) { E.fused(acc, cur, wr, wc, fr, fq, lds, wid, lane); S.done(cur); }
    PG8_STAMP();
    if (STAMP && wid == 0) { stamps[lane] = lane < nts ? (((unsigned long long)(unsigned)ts_hi << 32) | (unsigned)ts_lo) : 0ull;
        if (lane == 62) stamps[62] = rt_entry; if (lane == 63) stamps[63] = (unsigned long long)wall_clock64(); }
#undef PG8_STAMP
#undef PG8_SA
#undef PG8_SB
#undef PG8_STAGE
#undef PG8_LDA
#undef PG8_LDB
#undef PG8_MMA
#undef PG8_WAIT_V
#undef PG8_WAIT_L
#undef PG8_BAR
#undef PG8_SCHED
}
}
namespace fa {
using TIN = __hip_bfloat16; using TOUT = __hip_bfloat16;
constexpr int B = 8, H = 8, HKV = 8, SQ = 4096, SKV = 4096, D = 128;
constexpr int QOFF = 0; constexpr int WINDOW = SKV; constexpr float THR = 8.f;
constexpr bool WSKIP = false;
constexpr int OSTR = 2048;
constexpr float BSC = 11.313708498984761f;
constexpr float SCALE = 0.08838834764831845f;
constexpr int NW = 8, QBLK = 32, KVBLK = 64, QB = NW * QBLK;
constexpr int SHM_V = KVBLK * D * 2, SHM_K = KVBLK * D * 2;
constexpr int LDS_BYTES = 2 * SHM_V + 2 * SHM_K + NW * 64 * 4;
static_assert(D == 128 && SQ % QB == 0 && SKV % KVBLK == 0 && H % HKV == 0 && QOFF >= 0 && QOFF + SQ <= SKV && WINDOW >= 1, "geometry");

using bf16 = __hip_bfloat16;
typedef short bf16x8 __attribute__((ext_vector_type(8)));
typedef short s16x4 __attribute__((ext_vector_type(4)));
typedef float f32x16 __attribute__((ext_vector_type(16)));
typedef float f32x4 __attribute__((ext_vector_type(4)));
typedef unsigned u32x4 __attribute__((ext_vector_type(4)));
template <class A, class Bt> struct same_t { static constexpr bool v = false; };
template <class A> struct same_t<A, A> { static constexpr bool v = true; };

#define KSWZ(row, colB) ((row) * 256 + ((colB) ^ (((row) & 7) << 4)))
#define SBAR() __builtin_amdgcn_sched_barrier(0)
__device__ __forceinline__ int v_st(int k, int c) { const int kk = (k & ~0xC) | ((k & 4) << 1) | ((k & 8) >> 1); return ((kk >> 3) * 4 + (c >> 5)) * 512 + ((kk & 7) * 32 + (c & 31)) * 2; }
__device__ __forceinline__ int v_rd_base(int lane) { return ((lane & 3) << 3) | (((lane >> 2) & 3) << 6) | (((lane >> 4) & 1) << 5) | (((lane >> 5) & 1) << 8); }
constexpr int v_rd_off(int d0, int ks, int half) { return d0 * 512 + ks * 4096 + half * 2048; }
__device__ __forceinline__ int crow(int r, int hi) { return (r & 3) + 8 * (r >> 2) + 4 * hi; }
__device__ __forceinline__ unsigned cvtpk(float lo, float hi) {
    unsigned r; asm volatile("v_cvt_pk_bf16_f32 %0, %1, %2" : "=v"(r) : "v"(lo), "v"(hi)); return r;
}
__device__ __forceinline__ bf16x8 pack8(f32x4 a, f32x4 b) {
    u32x4 w = {cvtpk(a[0], a[1]), cvtpk(a[2], a[3]), cvtpk(b[0], b[1]), cvtpk(b[2], b[3])};
    return *reinterpret_cast<bf16x8*>(&w);
}
template <class T> __device__ __forceinline__ bf16x8 load8(const T* p) {
    if constexpr (same_t<T, float>::v) { return pack8(*(const f32x4*)p, *(const f32x4*)(p + 4)); }
    else { return *reinterpret_cast<const bf16x8*>(p); }
}
__device__ __forceinline__ void mask_tile(f32x16& p0, f32x16& p1, int dq, unsigned W) {
    const float NEG = -__builtin_inff();
#pragma unroll
    for (int r = 0; r < 16; ++r) {
        const int c = (r & 3) + 8 * (r >> 2);
        if ((unsigned)(dq - c) >= W) p0[r] = NEG;
        if ((unsigned)(dq - c - 32) >= W) p1[r] = NEG;
    }
}
__device__ __forceinline__ void partialSM(f32x16& p0, f32x16& p1, float& m_reg, float& mn, float& alpha) {
    float pmax = p0[0]; for (int r = 1; r < 16; ++r) pmax = fmaxf(pmax, p0[r]); for (int r = 0; r < 16; ++r) pmax = fmaxf(pmax, p1[r]);
    { auto rr = __builtin_amdgcn_permlane32_swap(__float_as_uint(pmax), __float_as_uint(pmax), false, false);
      pmax = fmaxf(__uint_as_float(rr[0]), __uint_as_float(rr[1])); }
    constexpr float C2 = 1.4426950408889634f * SCALE;
    if (__builtin_expect(__all((pmax - m_reg) * SCALE <= THR), 1)) { mn = m_reg; alpha = 1.f; }
    else { mn = fmaxf(m_reg, pmax); alpha = __builtin_amdgcn_exp2f((m_reg - mn) * C2); m_reg = mn; }
    const float mnL = -mn * C2;
    for (int r = 0; r < 16; ++r) p0[r] = fmaf(p0[r], C2, mnL); for (int r = 0; r < 16; ++r) p1[r] = fmaf(p1[r], C2, mnL);
    for (int r = 0; r < 16; ++r) p0[r] = __builtin_amdgcn_exp2f(p0[r]);
}
__device__ __forceinline__ void finishSM(f32x16& p0, f32x16& p1, float alpha, float& l_reg, bf16x8& pa0, bf16x8& pa1, bf16x8& pa2, bf16x8& pa3) {
    for (int r = 0; r < 16; ++r) p1[r] = __builtin_amdgcn_exp2f(p1[r]);
    float ps = 0; for (int r = 0; r < 16; ++r) ps += p0[r]; for (int r = 0; r < 16; ++r) ps += p1[r];
    { auto rr = __builtin_amdgcn_permlane32_swap(__float_as_uint(ps), __float_as_uint(ps), false, false);
      ps = __uint_as_float(rr[0]) + __uint_as_float(rr[1]); }
    l_reg = l_reg * alpha + ps;
#define PK4(P, B_, OUT) do { unsigned a0 = cvtpk(P[B_+0], P[B_+1]), a1 = cvtpk(P[B_+2], P[B_+3]);                          \
        unsigned b0 = cvtpk(P[B_+4], P[B_+5]), b1 = cvtpk(P[B_+6], P[B_+7]);                                             \
        auto r0 = __builtin_amdgcn_permlane32_swap(a0, b0, false, false); auto r1 = __builtin_amdgcn_permlane32_swap(a1, b1, false, false); \
        u32x4 w = {r0[0], r1[0], r0[1], r1[1]}; OUT = *reinterpret_cast<bf16x8*>(&w); } while (0)
    PK4(p0, 0, pa0); PK4(p0, 8, pa1); PK4(p1, 0, pa2); PK4(p1, 8, pa3);
#undef PK4
}
template <int KB, bool SK>
__device__ __forceinline__ void qkt(f32x16& p0, f32x16& p1, const char* K_lds, int r32, int hi, const bf16x8* qr, bool act) {
    if (SK && !act) { const float NEG = -__builtin_inff();
#pragma unroll
        for (int r = 0; r < 16; ++r) { p0[r] = NEG; p1[r] = NEG; } return; }
    p0 = f32x16{}; p1 = f32x16{};
    const char* kb[4];
#pragma unroll
    for (int dd = 0; dd < 4; ++dd) kb[dd] = K_lds + KB * SHM_K + KSWZ(r32, (dd * 16 + hi * 8) * 2);
#pragma unroll
    for (int d0 = 0; d0 < 8; ++d0) { const char* a = kb[d0 & 3] + (d0 >> 2) * 128;
        bf16x8 b0 = *reinterpret_cast<const bf16x8*>(a);
        bf16x8 b1 = *reinterpret_cast<const bf16x8*>(a + 32 * 256);
        p0 = __builtin_amdgcn_mfma_f32_32x32x16_bf16(b0, qr[d0], p0, 0, 0, 0);
        p1 = __builtin_amdgcn_mfma_f32_32x32x16_bf16(b1, qr[d0], p1, 0, 0, 0); }
}
template <int VB, bool SK>
__device__ __forceinline__ void pv_tile(f32x16* o, int vb0, bf16x8 pa0, bf16x8 pa1, bf16x8 pa2, bf16x8 pa3, bool act) {
    if (SK && !act) return;
#define TRRD(dst, off) asm volatile("ds_read_b64_tr_b16 %0, %1 offset:%2" : "=&v"(dst) : "v"(vb0), "i"(off) : "memory")
#define PV_D0(d0) do { s16x4 l0, l1, l2, l3, h0, h1, h2, h3; constexpr int b_ = VB * SHM_V + v_rd_off(d0, 0, 0);     \
        TRRD(l0, b_); TRRD(h0, b_ + 2048); TRRD(l1, b_ + 4096); TRRD(h1, b_ + 6144); TRRD(l2, b_ + 8192); TRRD(h2, b_ + 10240); TRRD(l3, b_ + 12288); TRRD(h3, b_ + 14336); \
        asm volatile("s_waitcnt lgkmcnt(0)" ::: "memory"); SBAR();                 \
        o[d0] = __builtin_amdgcn_mfma_f32_32x32x16_bf16(pa0, (bf16x8){l0[0], l0[1], l0[2], l0[3], h0[0], h0[1], h0[2], h0[3]}, o[d0], 0, 0, 0);   \
        o[d0] = __builtin_amdgcn_mfma_f32_32x32x16_bf16(pa1, (bf16x8){l1[0], l1[1], l1[2], l1[3], h1[0], h1[1], h1[2], h1[3]}, o[d0], 0, 0, 0);   \
        o[d0] = __builtin_amdgcn_mfma_f32_32x32x16_bf16(pa2, (bf16x8){l2[0], l2[1], l2[2], l2[3], h2[0], h2[1], h2[2], h2[3]}, o[d0], 0, 0, 0);   \
        o[d0] = __builtin_amdgcn_mfma_f32_32x32x16_bf16(pa3, (bf16x8){l3[0], l3[1], l3[2], l3[3], h3[0], h3[1], h3[2], h3[3]}, o[d0], 0, 0, 0); } while (0)
    PV_D0(0); PV_D0(1); PV_D0(2); PV_D0(3);
#undef PV_D0
#undef TRRD
}

template <class TIn, class TOut> struct BlockRef { const TIn* Q; const TIn* K; const TIn* V; TOut* O; int P0; };
template <class TIn> struct Seam {
    bf16x8 qr[8];
    bf16x8 st_v0, st_v1, st_k0, st_k1; f32x4 sf0, sf1, sf2, sf3;
    f32x4 tq[16];
};
__device__ __forceinline__ int swa_jlo(int P0, int W) { const int lowk = P0 - W + 1; return lowk > 0 ? lowk / KVBLK : 0; }
#define ROW(p, k0, rr) ((p) + (size_t)((k0) + (rr)) * D + sc)
#define VMW() asm volatile("s_waitcnt vmcnt(0)" ::: "memory")
#define VMWN(n) asm volatile("s_waitcnt vmcnt(%0)" :: "i"(n) : "memory")
#define SLOAD_H(Kp, Vp, k0) do { S.st_v0 = load8<TIn>(ROW(Vp, k0, sr)); S.st_v1 = load8<TIn>(ROW(Vp, k0, 32 + sr));              \
                         S.st_k0 = load8<TIn>(ROW(Kp, k0, sr)); S.st_k1 = load8<TIn>(ROW(Kp, k0, 32 + sr)); } while (0)
#define SWRITE_HK(bf) do { *(bf16x8*)(K_lds + (bf) * SHM_K + kws) = S.st_k0; *(bf16x8*)(K_lds + (bf) * SHM_K + kws + 32 * 256) = S.st_k1; } while (0)
#define SWRITE_HV(bf) do { *(bf16x8*)(V_lds + (bf) * SHM_V + vst0) = S.st_v0; *(bf16x8*)(V_lds + (bf) * SHM_V + vst1) = S.st_v1; } while (0)
#define SWRITE_H(bf) do { SWRITE_HV(bf); SWRITE_HK(bf); } while (0)
#define SLOAD_F(p, k0) do { S.sf0 = *(const f32x4*)ROW(p, k0, sr); S.sf1 = *(const f32x4*)(ROW(p, k0, sr) + 4);                \
                            S.sf2 = *(const f32x4*)ROW(p, k0, 32 + sr); S.sf3 = *(const f32x4*)(ROW(p, k0, 32 + sr) + 4); } while (0)
#define SWRITE_KF(bf) do { *(bf16x8*)(K_lds + (bf) * SHM_K + kws) = pack8(S.sf0, S.sf1); *(bf16x8*)(K_lds + (bf) * SHM_K + kws + 32 * 256) = pack8(S.sf2, S.sf3); } while (0)
#define SWRITE_VF(bf) do { *(bf16x8*)(V_lds + (bf) * SHM_V + vst0) = pack8(S.sf0, S.sf1); *(bf16x8*)(V_lds + (bf) * SHM_V + vst1) = pack8(S.sf2, S.sf3); } while (0)
template <class TIn, class TOut>
__device__ __forceinline__ void causal_swa_prime(const BlockRef<TIn, TOut>& cur, int W, char* lds, Seam<TIn>& S) {
    constexpr bool F32 = same_t<TIn, float>::v;
    const int tid = tidx(), wid = __builtin_amdgcn_readfirstlane(tid >> 6), lane = tid & 63, r32 = lane & 31, hi = lane >> 5;
    const int sr = tid >> 4, sc = (tid & 15) * 8, kws = KSWZ(sr, sc * 2); char* K_lds = lds + 2 * SHM_V;
    const int kb0 = swa_jlo(cur.P0, W) * KVBLK;
    for (int d0 = 0; d0 < 8; ++d0) S.qr[d0] = load8<TIn>(cur.Q + (size_t)(wid * QBLK + r32) * D + d0 * 16 + hi * 8);
    if constexpr (F32) { SLOAD_F((const float*)cur.K, kb0); VMW(); SWRITE_KF(0); SBAR(); SLOAD_F((const float*)cur.V, kb0); }
    else { SLOAD_H(cur.K, cur.V, kb0); VMW(); SWRITE_HK(0); }
    __syncthreads();
}
template <class TIn, class TOut>
__device__ __forceinline__ void causal_swa_block(const BlockRef<TIn, TOut>& cur, const BlockRef<TIn, TOut>& nxt, int skv, int W, char* lds, Seam<TIn>& S, const float* ckl) {
    constexpr bool F32 = same_t<TIn, float>::v;
    const int tid = tidx(), wid = __builtin_amdgcn_readfirstlane(tid >> 6), lane = tid & 63, r32 = lane & 31, hi = lane >> 5;
    const int j_lo = swa_jlo(cur.P0, W);
    int j_hi = (cur.P0 + QB - 1) / KVBLK + 1; if (j_hi > skv / KVBLK) j_hi = skv / KVBLK;
    const int NT = j_hi - j_lo;
    const int kbn = swa_jlo(nxt.P0, W) * KVBLK;
    const int qlo = cur.P0 + wid * QBLK, qm = qlo + r32 - 4 * hi;
    char* V_lds = lds; char* K_lds = lds + 2 * SHM_V;
    float* ws = (float*)(lds + 2 * SHM_V + 2 * SHM_K) + wid * 64; float* li_l = ws, * al_l = ws + 32;
    float m_reg = -1e30f, l_reg = 0; f32x16 o[4] = {};
    const float bq = ckl[cur.P0 + wid * QBLK + r32];
#define BIAST(P0_, P1_, t) do { const float* cb_ = ckl + KBASE(t) + 4 * hi;                                                       \
        _Pragma("unroll") for (int r4 = 0; r4 < 4; ++r4) { const f32x4 c0_ = *(const f32x4*)(cb_ + 8 * r4), c1_ = *(const f32x4*)(cb_ + 32 + 8 * r4); \
            _Pragma("unroll") for (int i_ = 0; i_ < 4; ++i_) { P0_[4 * r4 + i_] += bq - c0_[i_]; P1_[4 * r4 + i_] += bq - c1_[i_]; } } } while (0)
    const int sr = tid >> 4, sc = (tid & 15) * 8, vst0 = v_st(sr, sc), vst1 = v_st(32 + sr, sc), kws = KSWZ(sr, sc * 2);
    const int vb0 = (int)(uintptr_t)V_lds + v_rd_base(lane);
    const TIn* Kh = cur.K; const TIn* Vh = cur.V;
#define RESC(a) do { if (__any((a) < 1.f)) { if (hi == 0) al_l[r32] = (a); asm volatile("s_waitcnt lgkmcnt(0)" ::: "memory");              \
                     for (int d_ = 0; d_ < 4; ++d_) for (int r = 0; r < 16; ++r) o[d_][r] *= al_l[crow(r, hi)]; } } while (0)
#define KBASE(t) ((j_lo + (t)) * KVBLK)
#define ACT(t) (KBASE(t) <= qlo + QBLK - 1 && KBASE(t) + KVBLK - 1 >= qlo - W + 1)
#define MASKT(P0_, P1_, t) do { const int kb_ = KBASE(t); if ((!SK || ACT(t)) && (kb_ + KVBLK - 1 > qlo || kb_ <= qlo + QBLK - 1 - W)) mask_tile(P0_, P1_, qm - kb_, (unsigned)W); } while (0)
    constexpr int NQL = F32 ? 16 : 8;
    constexpr bool SK = WSKIP && !F32;
#define SEAM_K0() do { VMWN(NQL); if constexpr (F32) { SWRITE_KF(0); SBAR(); SLOAD_F((const float*)nxt.V, kbn); } else { SWRITE_HK(0); } SBAR(); } while (0)
    f32x16 pA0, pA1, pB0, pB1; float mnA, mnB, alA, alB; bf16x8 pa0, pa1, pa2, pa3;
    if constexpr (F32) { VMW(); SWRITE_VF(0); SBAR(); } else { SWRITE_HV(0); SBAR(); }
    if (NT > 1) { if constexpr (F32) SLOAD_F((const float*)Kh, KBASE(1)); else SLOAD_H(Kh, Vh, KBASE(1)); }
    SBAR(); qkt<0, SK>(pA0, pA1, K_lds, r32, hi, S.qr, ACT(0));
    if constexpr (F32) { if (NT > 1) { VMW(); SWRITE_KF(1); SBAR(); SLOAD_F((const float*)Vh, KBASE(1)); } }
    BIAST(pA0, pA1, 0); MASKT(pA0, pA1, 0); partialSM(pA0, pA1, m_reg, mnA, alA);
    if (NT > 1) { VMW(); if constexpr (F32) { SWRITE_VF(1); SBAR(); if (NT > 2) SLOAD_F((const float*)Kh, KBASE(2)); } else SWRITE_H(1); }
    __syncthreads();
#define HALF_STEP(PX0, PX1, mnX, alX, PY0, PY1, alY, t, KB, VB, SB) do {                                                      \
        SBAR(); qkt<KB, SK>(PX0, PX1, K_lds, r32, hi, S.qr, ACT(t));                                             \
        finishSM(PY0, PY1, alY, l_reg, pa0, pa1, pa2, pa3); SBAR();                                                           \
        if ((t) + 1 < NT) { if constexpr (F32) { VMW(); SWRITE_KF(SB); SBAR(); SLOAD_F((const float*)Vh, KBASE((t) + 1)); }  \
                            else { SLOAD_H(Kh, Vh, KBASE((t) + 1)); } SBAR(); }                                               \
        pv_tile<VB, SK>(o, vb0, pa0, pa1, pa2, pa3, ACT((t) - 1)); BIAST(PX0, PX1, (t)); MASKT(PX0, PX1, (t)); partialSM(PX0, PX1, m_reg, mnX, alX);                                        \
        __syncthreads();                                                                                                      \
        if ((t) + 1 < NT) { VMW(); if constexpr (F32) { SWRITE_VF(SB); SBAR(); if ((t) + 2 < NT) SLOAD_F((const float*)Kh, KBASE((t) + 2)); } \
                            else { SWRITE_H(SB); } }                                                                          \
        RESC(alX); __syncthreads(); } while (0)
    for (int t = 1; t + 1 < NT; t += 2) {
        HALF_STEP(pB0, pB1, mnB, alB, pA0, pA1, alA, t, 1, 0, 0);
        HALF_STEP(pA0, pA1, mnA, alA, pB0, pB1, alB, t + 1, 0, 1, 1);
    }
    const bool even = (NT & 1) == 0;
    if (even) { SBAR(); qkt<1, SK>(pB0, pB1, K_lds, r32, hi, S.qr, ACT(NT - 1)); SBAR(); }
#define QROW(e) (nxt.Q + (size_t)(wid * QBLK + r32) * D + ((e) >> 1) * 16 + hi * 8 + ((e) & 1) * 4)
    if constexpr (F32) { SLOAD_F((const float*)nxt.K, kbn); SBAR();
#pragma unroll
        for (int e = 0; e < 8; ++e) S.tq[e] = *(const f32x4*)QROW(e); }
    else { SLOAD_H(nxt.K, nxt.V, kbn); SBAR();
#pragma unroll
        for (int d0 = 0; d0 < 8; ++d0) S.qr[d0] = load8<TIn>(nxt.Q + (size_t)(wid * QBLK + r32) * D + d0 * 16 + hi * 8); }
    SBAR();
    finishSM(pA0, pA1, alA, l_reg, pa0, pa1, pa2, pa3); SBAR();
    if constexpr (F32) {
#pragma unroll
        for (int e = 8; e < 16; ++e) S.tq[e] = *(const f32x4*)QROW(e); SBAR(); }
#undef QROW
    pv_tile<0, SK>(o, vb0, pa0, pa1, pa2, pa3, ACT(even ? NT - 2 : NT - 1));
    if (even) { BIAST(pB0, pB1, NT - 1); MASKT(pB0, pB1, NT - 1); partialSM(pB0, pB1, m_reg, mnB, alB); __syncthreads(); RESC(alB);
        finishSM(pB0, pB1, alB, l_reg, pa0, pa1, pa2, pa3); SBAR(); pv_tile<1, SK>(o, vb0, pa0, pa1, pa2, pa3, ACT(NT - 1)); }
    SBAR(); SEAM_K0();
    if (hi == 0) li_l[r32] = l_reg; asm volatile("s_waitcnt lgkmcnt(0)" ::: "memory");
    float rli[16];
#pragma unroll
    for (int r = 0; r < 16; ++r) rli[r] = __builtin_amdgcn_rcpf(li_l[crow(r, hi)]);
    TOut* Ow = cur.O + (size_t)(wid * QBLK) * OSTR;
#pragma unroll
    for (int r = 0; r < 16; ++r) { const int orow = crow(r, hi);
#pragma unroll
        for (int d0 = 0; d0 < 4; ++d0) { const float v = o[d0][r] * rli[r];
            if constexpr (same_t<TOut, float>::v) { Ow[(size_t)orow * OSTR + d0 * 32 + r32] = v; }
            else { const float vn = __shfl_xor(v, 1);
                   if ((r32 & 1) == 0) *(unsigned*)(Ow + (size_t)orow * OSTR + d0 * 32 + r32) = cvtpk(v, vn); } } }
    if constexpr (F32) {
#pragma unroll
        for (int d0 = 0; d0 < 8; ++d0) S.qr[d0] = pack8(S.tq[2 * d0], S.tq[2 * d0 + 1]); }
    __syncthreads();
#undef RESC
#undef BIAST
#undef KBASE
#undef ACT
#undef MASKT
#undef SEAM_K0
#undef HALF_STEP
}
#undef ROW
#undef VMW
#undef VMWN
#undef SLOAD_H
#undef SWRITE_HK
#undef SWRITE_HV
#undef SWRITE_H
#undef SLOAD_F
#undef SWRITE_KF
#undef SWRITE_VF

}
#define DI __device__ __forceinline__
typedef unsigned short bf16_t;
typedef short bf16x8 __attribute__((ext_vector_type(8)));
typedef float f32x4 __attribute__((ext_vector_type(4)));
typedef unsigned u32x4 __attribute__((ext_vector_type(4)));
typedef unsigned u32x2 __attribute__((ext_vector_type(2)));
using pg8::cvt_pk_bf16;
constexpr int MT = 32768, DM = 1024, SEQ = 4096, NBAT = 8, DFF = 2816, NTHR = 512;
constexpr float EPS = 1e-6f;
constexpr int LDS_TOTAL = 131072;

constexpr size_t SZ_WFIN = 5632ull * 1024 * 2, SZ_WFOUT = 1024ull * 2816 * 2;
constexpr size_t OFF_WFIN = 0;
constexpr size_t OFF_WFOUT = 2 * SZ_WFIN;
constexpr size_t OFF_WMIN = OFF_WFOUT + 2 * SZ_WFOUT;
constexpr size_t OFF_WMOUT = OFF_WMIN + 5888ull * 1024 * 2;
constexpr size_t OFF_WG = OFF_WMOUT + 1024ull * 2048 * 2;
constexpr size_t OFF_YCAT = OFF_WG + 8ull * 256 * 128 * 2;
constexpr size_t OFF_XBCP = OFF_YCAT + (size_t)MT * 2048 * 2;
constexpr size_t OFF_QKV = OFF_XBCP + (size_t)MT * 1536 * 2;
constexpr size_t OFF_ST = OFF_QKV + 3ull * MT * 1024 * 2;
constexpr size_t OFF_XN = OFF_ST + (size_t)MT * 1024 * 2;
constexpr size_t OFF_MISC = OFF_XN + (size_t)MT * 1536 * 2;
constexpr size_t OFF_CUM = OFF_MISC + (size_t)MT * 32 * 4;
constexpr size_t OFF_DT = OFF_CUM + 64ull * 4096 * 4;
constexpr size_t OFF_ACS = OFF_DT + (size_t)MT * 16 * 4;
constexpr size_t OFF_RH = OFF_ACS + (size_t)MT * 16 * 4;
constexpr size_t OFF_RA = OFF_RH + 8ull * 64 * 1024 * 4;
constexpr size_t OFF_RC = OFF_RA + 8ull * 64 * 1024 * 4;
constexpr size_t WS_END = OFF_RC + 8ull * 64 * 1024 * 4;

struct Params {
    const float* x; const float* norm_g; const float* ffn_w_in; const float* ffn_w_out; const float* hyb_w_in; const float* ssm_conv_w; const float* ssm_conv_b;
    const float* ssm_dt_bias; const float* ssm_a_log; const float* ssm_d; const float* ssm_norm_g; const float* fox_b_f; const float* hyb_w_out;
    const float* rec_w_in; const float* rec_conv_w; const float* rec_conv_b; const float* rec_w_a; const float* rec_b_a; const float* rec_w_x; const float* rec_b_x;
    const float* rec_lambda; const float* rec_w_out;
    float* out; unsigned char* ws; int ph_lo, ph_hi;
};

DI bf16_t f2bf(float f) { unsigned u = __float_as_uint(f); u += 0x7FFFu + ((u >> 16) & 1u); return (bf16_t)(u >> 16); }
DI float bf2f(bf16_t b) { return __uint_as_float(((unsigned)b) << 16); }
DI float bflo(unsigned w) { return __uint_as_float(w << 16); }
DI float bfhi(unsigned w) { return __uint_as_float(w & 0xFFFF0000u); }
DI float sigmoidf_(float x) { return 1.0f / (1.0f + __expf(-x)); }
DI float siluf_(float x) { return x / (1.0f + __expf(-x)); }
DI float softplusf_(float x) { return x > 20.f ? x : log1pf(__expf(x)); }
DI float logsigf_(float x) { return fminf(x, 0.f) - log1pf(__expf(-fabsf(x))); }
DI float geluf_(float x) { const float t = 1.5957691216057308f * (x + 0.044715f * x * x * x); return x / (1.0f + __expf(-t)); }
#define MFMA16(a, b, c) __builtin_amdgcn_mfma_f32_16x16x32_bf16((a), (b), (c), 0, 0, 0)

struct EpiPlain {
    static constexpr bool PERM = true, AFTER_DRAIN = false;
    bf16_t* O; int ldc;
    DI void operator()(const pg8::f32x4 (&acc)[2][2][4][2], const pg8::Unit& u, int wr, int wc, int fr, int fq) const {
        const int row0 = u.pm * 256 + wr * 64 + fr, col0 = u.pn * 256 + wc * 32 + 8 * fq;
#pragma unroll
        for (int ai = 0; ai < 2; ++ai)
#pragma unroll
            for (int m = 0; m < 4; ++m) { bf16_t* rowp = O + (size_t)(row0 + ai * 128 + m * 16) * ldc + col0;
#pragma unroll
                for (int bj = 0; bj < 2; ++bj) { const pg8::f32x4 v0 = acc[ai][bj][m][0], v1 = acc[ai][bj][m][1];
                    u32x4 w; w.x = cvt_pk_bf16(v0[0], v0[1]); w.y = cvt_pk_bf16(v0[2], v0[3]); w.z = cvt_pk_bf16(v1[0], v1[1]); w.w = cvt_pk_bf16(v1[2], v1[3]);
                    *(u32x4*)(rowp + bj * 128) = w; } }
    }
};
struct EpiSwiglu {
    static constexpr bool PERM = true, AFTER_DRAIN = false;
    bf16_t* O;
    DI void operator()(const pg8::f32x4 (&acc)[2][2][4][2], const pg8::Unit& u, int wr, int wc, int fr, int fq) const {
        const int row0 = u.pm * 256 + wr * 64 + fr, col0 = u.pn * 128 + wc * 32 + 8 * fq;
#pragma unroll
        for (int ai = 0; ai < 2; ++ai)
#pragma unroll
            for (int m = 0; m < 4; ++m) { bf16_t* rowp = O + (size_t)(row0 + ai * 128 + m * 16) * DFF + col0;
                float h[8];
#pragma unroll
                for (int n = 0; n < 2; ++n)
#pragma unroll
                    for (int j = 0; j < 4; ++j) h[n * 4 + j] = siluf_(acc[ai][0][m][n][j]) * acc[ai][1][m][n][j];
                u32x4 w; w.x = cvt_pk_bf16(h[0], h[1]); w.y = cvt_pk_bf16(h[2], h[3]); w.z = cvt_pk_bf16(h[4], h[5]); w.w = cvt_pk_bf16(h[6], h[7]);
                *(u32x4*)rowp = w; }
    }
};
struct EpiHyb {
    static constexpr bool PERM = true, AFTER_DRAIN = false;
    bf16_t* ycat; bf16_t* xbcp; bf16_t* qkv; float* misc;
    DI void operator()(const pg8::f32x4 (&acc)[2][2][4][2], const pg8::Unit& u, int wr, int wc, int fr, int fq) const {
        const int row0 = u.pm * 256 + wr * 64 + fr, pn = u.pn;
        if (pn == 22) {
            if (wc == 0) {
#pragma unroll
                for (int ai = 0; ai < 2; ++ai)
#pragma unroll
                    for (int m = 0; m < 4; ++m) { float* rowp = misc + (size_t)(row0 + ai * 128 + m * 16) * 32 + 8 * fq;
                        *(pg8::f32x4*)rowp = acc[ai][0][m][0]; *(pg8::f32x4*)(rowp + 4) = acc[ai][0][m][1]; }
            }
            return;
        }
#pragma unroll
        for (int ai = 0; ai < 2; ++ai)
#pragma unroll
            for (int m = 0; m < 4; ++m) { const int r = row0 + ai * 128 + m * 16;
#pragma unroll
                for (int bj = 0; bj < 2; ++bj) { const pg8::f32x4 v0 = acc[ai][bj][m][0], v1 = acc[ai][bj][m][1];
                    u32x4 w; w.x = cvt_pk_bf16(v0[0], v0[1]); w.y = cvt_pk_bf16(v0[2], v0[3]); w.z = cvt_pk_bf16(v1[0], v1[1]); w.w = cvt_pk_bf16(v1[2], v1[3]);
                    const int cl = bj * 128 + wc * 32 + 8 * fq;
                    bf16_t* dst;
                    if (pn < 4) dst = ycat + (size_t)r * 2048 + pn * 256 + cl;
                    else if (pn < 10) dst = xbcp + (size_t)r * 1536 + (pn - 4) * 256 + cl;
                    else { const int t = (pn - 10) >> 2, head = ((pn - 10) & 3) * 2 + bj, b = r >> 12, s = r & 4095;
                        dst = qkv + (size_t)t * ((size_t)MT * 1024) + ((size_t)(b * 8 + head) * SEQ + s) * 128 + wc * 32 + 8 * fq; }
                    *(u32x4*)dst = w; } }
    }
};
struct EpiRec {
    static constexpr bool PERM = true, AFTER_DRAIN = false;
    bf16_t* G; bf16_t* X;
    DI void operator()(const pg8::f32x4 (&acc)[2][2][4][2], const pg8::Unit& u, int wr, int wc, int fr, int fq) const {
        const int row0 = u.pm * 256 + wr * 64 + fr; const bool isg = u.pn < 4;
        bf16_t* base = (isg ? G : X) + (u.pn & 3) * 256 + wc * 32 + 8 * fq;
#pragma unroll
        for (int ai = 0; ai < 2; ++ai)
#pragma unroll
            for (int m = 0; m < 4; ++m) { bf16_t* rowp = base + (size_t)(row0 + ai * 128 + m * 16) * 1024;
#pragma unroll
                for (int bj = 0; bj < 2; ++bj) { pg8::f32x4 v0 = acc[ai][bj][m][0], v1 = acc[ai][bj][m][1];
                    if (isg) {
#pragma unroll
                        for (int j = 0; j < 4; ++j) { v0[j] = geluf_(v0[j]); v1[j] = geluf_(v1[j]); } }
                    u32x4 w; w.x = cvt_pk_bf16(v0[0], v0[1]); w.y = cvt_pk_bf16(v0[2], v0[3]); w.z = cvt_pk_bf16(v1[0], v1[1]); w.w = cvt_pk_bf16(v1[2], v1[3]);
                    *(u32x4*)(rowp + bj * 128) = w; } }
    }
};
template <class Epi> DI void run_gemm(unsigned char* shm, const bf16_t* A, const bf16_t* Bt, int N, int K, const Epi& E) {
    pg8::Gemm g; g.A = A; g.Bt = Bt; g.M = MT; g.N = N; g.K = K;
    pg8::StaticOrder S; S.init(MT, N, (int)gridDim.x, (int)bidx());
    pg8::gemm_phase<Epi, pg8::StaticOrder, false>((PG8_LAS unsigned char*)shm, g, S, E, nullptr);
    __syncthreads();
}

DI int srccol(int map, int j) {
    if (map == 0) return j;
    if (map == 1) { const int pn = j >> 8, c = j & 255; return c < 128 ? pn * 128 + c : DFF + pn * 128 + (c - 128); }
    if (j < 2560) return j;
    if (j < 5632) return j + 16;
    if (j < 5648) return 2560 + (j - 5632);
    if (j < 5656) return j;
    return -1;
}
DI void transpose_job(unsigned char* shm, const float* src, int ld, int K, int N, bf16_t* dst, int map, int rot) {
    float* tile = (float*)shm;
    const int tk = K >> 6, ntiles = (N >> 6) * tk, tid = tidx();
    const int start = (int)((bidx() + gridDim.x - (rot % gridDim.x)) % gridDim.x);
    for (int t = start; t < ntiles; t += gridDim.x) {
        const int j0 = (t / tk) << 6, k0 = (t % tk) << 6;
        const int jj = tid & 63, sc = srccol(map, j0 + jj);
#pragma unroll
        for (int i = 0; i < 8; ++i) { const int kk = (tid >> 6) + 8 * i; tile[kk * 65 + jj] = sc >= 0 ? src[(size_t)(k0 + kk) * ld + sc] : 0.f; }
        __syncthreads();
        const int k2 = (tid & 31) * 2;
#pragma unroll
        for (int i = 0; i < 4; ++i) { const int jr = (tid >> 5) + 16 * i;
            *(unsigned*)(dst + (size_t)(j0 + jr) * K + k0 + k2) = cvt_pk_bf16(tile[k2 * 65 + jr], tile[(k2 + 1) * 65 + jr]); }
        __syncthreads();
    }
}
DI void convert_weights(unsigned char* shm, const Params& p, int layer) {
    unsigned char* ws = p.ws; int rot = 0;
    for (int s = 0; s < 2; ++s) {
        transpose_job(shm, p.ffn_w_in + (size_t)(layer * 2 + s) * 1024 * 5632, 5632, 1024, 5632, (bf16_t*)(ws + OFF_WFIN + s * SZ_WFIN), 1, rot); rot += 88 * 16;
        transpose_job(shm, p.ffn_w_out + (size_t)(layer * 2 + s) * 2816 * 1024, 1024, 2816, 1024, (bf16_t*)(ws + OFF_WFOUT + s * SZ_WFOUT), 0, rot); rot += 16 * 44;
    }
    const int i = layer >> 1;
    if ((layer & 1) == 0) {
        transpose_job(shm, p.hyb_w_in + (size_t)i * 1024 * 5656, 5656, 1024, 5888, (bf16_t*)(ws + OFF_WMIN), 2, rot); rot += 92 * 16;
        transpose_job(shm, p.hyb_w_out + (size_t)i * 2048 * 1024, 1024, 2048, 1024, (bf16_t*)(ws + OFF_WMOUT), 0, rot);
    } else {
        transpose_job(shm, p.rec_w_in + (size_t)i * 1024 * 2048, 2048, 1024, 2048, (bf16_t*)(ws + OFF_WMIN), 0, rot); rot += 32 * 16;
        transpose_job(shm, p.rec_w_out + (size_t)i * 1024 * 1024, 1024, 1024, 1024, (bf16_t*)(ws + OFF_WMOUT), 0, rot); rot += 16 * 16;
        for (int nb = 0; nb < 8; ++nb) {
            transpose_job(shm, p.rec_w_a + ((size_t)i * 8 + nb) * 128 * 128, 128, 128, 128, (bf16_t*)(ws + OFF_WG) + (size_t)nb * 256 * 128, 0, rot); rot += 4;
            transpose_job(shm, p.rec_w_x + ((size_t)i * 8 + nb) * 128 * 128, 128, 128, 128, (bf16_t*)(ws + OFF_WG) + (size_t)nb * 256 * 128 + 128 * 128, 0, rot); rot += 4;
        }
    }
}

DI void resnorm_phase(const float* xin, const bf16_t* h, float w, const float* gpost, const float* gpre, float* xout, bf16_t* xn) {
    const int lane = tidx() & 63, gw = bidx() * 8 + (tidx() >> 6), nw = gridDim.x * 8;
    for (int r = gw; r < MT; r += nw) {
        f32x4 xv[4];
#pragma unroll
        for (int i = 0; i < 4; ++i) xv[i] = *(const f32x4*)(xin + (size_t)r * DM + i * 256 + lane * 4);
        if (h) {
            float hv[4][4]; float ss = 0.f;
#pragma unroll
            for (int i = 0; i < 4; ++i) { const u32x2 q = *(const u32x2*)(h + (size_t)r * DM + i * 256 + lane * 4);
                hv[i][0] = bflo(q.x); hv[i][1] = bfhi(q.x); hv[i][2] = bflo(q.y); hv[i][3] = bfhi(q.y);
                ss += hv[i][0] * hv[i][0] + hv[i][1] * hv[i][1] + hv[i][2] * hv[i][2] + hv[i][3] * hv[i][3]; }
#pragma unroll
            for (int o = 32; o > 0; o >>= 1) ss += __shfl_xor(ss, o);
            const float sc = w * rsqrtf(ss * (1.0f / DM) + EPS);
#pragma unroll
            for (int i = 0; i < 4; ++i) { const f32x4 g = *(const f32x4*)(gpost + i * 256 + lane * 4);
#pragma unroll
                for (int j = 0; j < 4; ++j) xv[i][j] += sc * hv[i][j] * g[j]; }
        }
#pragma unroll
        for (int i = 0; i < 4; ++i) *(f32x4*)(xout + (size_t)r * DM + i * 256 + lane * 4) = xv[i];
        if (gpre) {
            float ss = 0.f;
#pragma unroll
            for (int i = 0; i < 4; ++i) ss += xv[i][0] * xv[i][0] + xv[i][1] * xv[i][1] + xv[i][2] * xv[i][2] + xv[i][3] * xv[i][3];
#pragma unroll
            for (int o = 32; o > 0; o >>= 1) ss += __shfl_xor(ss, o);
            const float sc = rsqrtf(ss * (1.0f / DM) + EPS);
#pragma unroll
            for (int i = 0; i < 4; ++i) { const f32x4 g = *(const f32x4*)(gpre + i * 256 + lane * 4);
                u32x2 q; q.x = cvt_pk_bf16(xv[i][0] * sc * g[0], xv[i][1] * sc * g[1]); q.y = cvt_pk_bf16(xv[i][2] * sc * g[2], xv[i][3] * sc * g[3]);
                *(u32x2*)(xn + (size_t)r * DM + i * 256 + lane * 4) = q; }
        }
    }
}
DI void hyb_prep_phase(unsigned char* shm, const Params& p, int li) {
    unsigned char* ws = p.ws; const int tid = tidx(), lane = tid & 63, wid = tid >> 6;
    const float* misc = (const float*)(ws + OFF_MISC);
    { float* cum = (float*)(ws + OFF_CUM); float* sw = (float*)shm;
      for (int it = bidx(); it < 64; it += gridDim.x) {
        const int b = it >> 3, h = it & 7; const float bf = p.fox_b_f[li * 8 + h];
        float v[8]; float run = 0.f;
#pragma unroll
        for (int j = 0; j < 8; ++j) { const float fr_ = misc[(size_t)(b * SEQ + tid * 8 + j) * 32 + 16 + h]; run += logsigf_(fr_ + bf); v[j] = run; }
        float inc = run;
#pragma unroll
        for (int o = 1; o < 64; o <<= 1) { const float t = __shfl_up(inc, o); if (lane >= o) inc += t; }
        if (lane == 63) sw[wid] = inc;
        __syncthreads();
        float base = inc - run;
        for (int w2 = 0; w2 < wid; ++w2) base += sw[w2];
#pragma unroll
        for (int j = 0; j < 8; ++j) cum[(size_t)it * SEQ + tid * 8 + j] = base + v[j];
        __syncthreads();
      } }
    { float* dtb = (float*)(ws + OFF_DT); float* acs = (float*)(ws + OFF_ACS); float* sA = (float*)shm;
      for (int it = bidx(); it < 256; it += gridDim.x) {
        const int tok0 = it * 128, l = tid >> 2, hq = (tid & 3) * 4;
        const f32x4 raw = *(const f32x4*)(misc + (size_t)(tok0 + l) * 32 + hq);
        f32x4 dtv;
#pragma unroll
        for (int j = 0; j < 4; ++j) { dtv[j] = softplusf_(raw[j] + p.ssm_dt_bias[li * 16 + hq + j]); sA[l * 16 + hq + j] = dtv[j] * (-__expf(p.ssm_a_log[li * 16 + hq + j])); }
        *(f32x4*)(dtb + (size_t)(tok0 + l) * 16 + hq) = dtv;
        __syncthreads();
        if (tid < 16) { float run = 0.f; for (int q = 0; q < 128; ++q) { run += sA[q * 16 + tid]; sA[q * 16 + tid] = run; } }
        __syncthreads();
        *(f32x4*)(acs + (size_t)(tok0 + l) * 16 + hq) = *(const f32x4*)(sA + l * 16 + hq);
        __syncthreads();
      } }
    { const bf16_t* src = (const bf16_t*)(ws + OFF_XBCP); bf16_t* dst = (bf16_t*)(ws + OFF_XN);
      const float* cw = p.ssm_conv_w + (size_t)li * 4 * 1536; const float* cb = p.ssm_conv_b + (size_t)li * 1536;
      const int total = (MT / 16) * 192;
      for (int idx = bidx() * NTHR + tid; idx < total; idx += gridDim.x * NTHR) {
        const int tb = idx / 192, c0 = (idx % 192) * 8, t0 = tb * 16, s0 = t0 & (SEQ - 1);
        float w[4][8], bias[8];
#pragma unroll
        for (int k = 0; k < 4; ++k) { const f32x4 a = *(const f32x4*)(cw + k * 1536 + c0), b2 = *(const f32x4*)(cw + k * 1536 + c0 + 4);
#pragma unroll
            for (int j = 0; j < 4; ++j) { w[k][j] = a[j]; w[k][4 + j] = b2[j]; } }
        { const f32x4 a = *(const f32x4*)(cb + c0), b2 = *(const f32x4*)(cb + c0 + 4);
#pragma unroll
          for (int j = 0; j < 4; ++j) { bias[j] = a[j]; bias[4 + j] = b2[j]; } }
        float h0[8], h1[8], h2[8];
#pragma unroll
        for (int j = 0; j < 8; ++j) { h0[j] = 0.f; h1[j] = 0.f; h2[j] = 0.f; }
        if (s0 > 0) {
            const u32x4 a = *(const u32x4*)(src + (size_t)(t0 - 3) * 1536 + c0), b2 = *(const u32x4*)(src + (size_t)(t0 - 2) * 1536 + c0), c2 = *(const u32x4*)(src + (size_t)(t0 - 1) * 1536 + c0);
#pragma unroll
            for (int j = 0; j < 4; ++j) { h0[2 * j] = bflo(a[j]); h0[2 * j + 1] = bfhi(a[j]); h1[2 * j] = bflo(b2[j]); h1[2 * j + 1] = bfhi(b2[j]); h2[2 * j] = bflo(c2[j]); h2[2 * j + 1] = bfhi(c2[j]); }
        }
#pragma unroll 4
        for (int q = 0; q < 16; ++q) {
            const u32x4 a = *(const u32x4*)(src + (size_t)(t0 + q) * 1536 + c0);
            float cur[8], y[8];
#pragma unroll
            for (int j = 0; j < 4; ++j) { cur[2 * j] = bflo(a[j]); cur[2 * j + 1] = bfhi(a[j]); }
#pragma unroll
            for (int j = 0; j < 8; ++j) { y[j] = siluf_(bias[j] + w[0][j] * h0[j] + w[1][j] * h1[j] + w[2][j] * h2[j] + w[3][j] * cur[j]); h0[j] = h1[j]; h1[j] = h2[j]; h2[j] = cur[j]; }
            u32x4 o; o.x = cvt_pk_bf16(y[0], y[1]); o.y = cvt_pk_bf16(y[2], y[3]); o.z = cvt_pk_bf16(y[4], y[5]); o.w = cvt_pk_bf16(y[6], y[7]);
            *(u32x4*)(dst + (size_t)(t0 + q) * 1536 + c0) = o;
        }
      } }
}

constexpr int LDT = 136;
DI void ssd_states_phase(unsigned char* shm, const Params& p) {
    unsigned char* ws = p.ws; const int tid = tidx(), lane = tid & 63, w = __builtin_amdgcn_readfirstlane(tid >> 6), fr = lane & 15, fq = lane >> 4;
    const bf16_t* xbc = (const bf16_t*)(ws + OFF_XN); const float* dtb = (const float*)(ws + OFF_DT); const float* acs = (const float*)(ws + OFF_ACS);
    bf16_t* st = (bf16_t*)(ws + OFF_ST);
    bf16_t* Bt = (bf16_t*)shm;
    bf16_t* Xt = Bt + 128 * LDT;
    for (int it = bidx(); it < 512; it += gridDim.x) {
        const int g = it & 1, bc = it >> 1, tok0 = bc * 128;
#pragma unroll
        for (int i = 0; i < 4; ++i) { const int v = tid + i * NTHR, l = v >> 4, n8 = (v & 15) * 8;
            const u32x4 q = *(const u32x4*)(xbc + (size_t)(tok0 + l) * 1536 + 1024 + g * 128 + n8);
#pragma unroll
            for (int j = 0; j < 4; ++j) { Bt[(n8 + 2 * j) * LDT + l] = (bf16_t)(q[j] & 0xFFFFu); Bt[(n8 + 2 * j + 1) * LDT + l] = (bf16_t)(q[j] >> 16); } }
        for (int k = 0; k < 8; ++k) {
            const int hh = g * 8 + k; const float aend = acs[(size_t)(tok0 + 127) * 16 + hh];
            __syncthreads();
#pragma unroll
            for (int i = 0; i < 2; ++i) { const int v = tid + i * NTHR, l = v >> 3, p8 = (v & 7) * 8;
                const float wl = __expf(aend - acs[(size_t)(tok0 + l) * 16 + hh]) * dtb[(size_t)(tok0 + l) * 16 + hh];
                const u32x4 q = *(const u32x4*)(xbc + (size_t)(tok0 + l) * 1536 + hh * 64 + p8);
#pragma unroll
                for (int j = 0; j < 4; ++j) { Xt[(p8 + 2 * j) * LDT + l] = f2bf(bflo(q[j]) * wl); Xt[(p8 + 2 * j + 1) * LDT + l] = f2bf(bfhi(q[j]) * wl); } }
            __syncthreads();
            f32x4 acc[4];
#pragma unroll
            for (int j = 0; j < 4; ++j) acc[j] = (f32x4){0.f, 0.f, 0.f, 0.f};
#pragma unroll
            for (int ks = 0; ks < 4; ++ks) { const bf16x8 a = *(const bf16x8*)(Bt + (16 * w + fr) * LDT + 32 * ks + 8 * fq);
#pragma unroll
                for (int j = 0; j < 4; ++j) { const bf16x8 b = *(const bf16x8*)(Xt + (16 * j + fr) * LDT + 32 * ks + 8 * fq); acc[j] = MFMA16(a, b, acc[j]); } }
            bf16_t* sp = st + ((size_t)bc * 16 + hh) * 8192;
#pragma unroll
            for (int j = 0; j < 4; ++j) { u32x2 o; o.x = cvt_pk_bf16(acc[j][0], acc[j][1]); o.y = cvt_pk_bf16(acc[j][2], acc[j][3]);
                *(u32x2*)(sp + (16 * j + fr) * 128 + 16 * w + 4 * fq) = o; }
        }
        __syncthreads();
    }
}
DI void ssd_carry_phase(const Params& p) {
    unsigned char* ws = p.ws; const float* acs = (const float*)(ws + OFF_ACS); bf16_t* st = (bf16_t*)(ws + OFF_ST);
    for (int idx = bidx() * NTHR + tidx(); idx < 128 * 1024; idx += gridDim.x * NTHR) {
        const int bh = idx >> 10, e8 = (idx & 1023) * 8, b = bh >> 4, h = bh & 15;
        float carry[8];
#pragma unroll
        for (int j = 0; j < 8; ++j) carry[j] = 0.f;
        for (int z0 = 0; z0 < 32; z0 += 8) {
            u32x4 q[8]; float dec[8];
#pragma unroll
            for (int zz = 0; zz < 8; ++zz) { const int z = z0 + zz; q[zz] = *(const u32x4*)(st + ((size_t)(b * 32 + z) * 16 + h) * 8192 + e8);
                dec[zz] = __expf(acs[(size_t)(b * SEQ + z * 128 + 127) * 16 + h]); }
#pragma unroll
            for (int zz = 0; zz < 8; ++zz) { const int z = z0 + zz;
                u32x4 o; o.x = cvt_pk_bf16(carry[0], carry[1]); o.y = cvt_pk_bf16(carry[2], carry[3]); o.z = cvt_pk_bf16(carry[4], carry[5]); o.w = cvt_pk_bf16(carry[6], carry[7]);
                *(u32x4*)(st + ((size_t)(b * 32 + z) * 16 + h) * 8192 + e8) = o;
#pragma unroll
                for (int j = 0; j < 4; ++j) { carry[2 * j] = carry[2 * j] * dec[zz] + bflo(q[zz][j]); carry[2 * j + 1] = carry[2 * j + 1] * dec[zz] + bfhi(q[zz][j]); } }
        }
    }
}

DI void ssd_out_phase(unsigned char* shm, const Params& p, int li) {
    unsigned char* ws = p.ws; const int tid = tidx(), lane = tid & 63, w = __builtin_amdgcn_readfirstlane(tid >> 6), fr = lane & 15, fq = lane >> 4;
    const bf16_t* xbc = (const bf16_t*)(ws + OFF_XN); const float* dtb = (const float*)(ws + OFF_DT); const float* acs = (const float*)(ws + OFF_ACS);
    const bf16_t* st = (const bf16_t*)(ws + OFF_ST); bf16_t* ycat = (bf16_t*)(ws + OFF_YCAT);
    bf16_t* Cs = (bf16_t*)shm; bf16_t* Bs = Cs + 128 * LDT; bf16_t* Ml = Bs + 128 * LDT; bf16_t* Xt = Ml + 128 * LDT;
    float* acs_s = (float*)(Xt + 64 * LDT); float* ssq = acs_s + 128;
    for (int it = bidx(); it < 512; it += gridDim.x) {
        const int g = it & 1, bc = it >> 1, tok0 = bc * 128;
        __syncthreads();
#pragma unroll
        for (int i = 0; i < 4; ++i) { const int v = tid + i * NTHR, l = v >> 4, n8 = (v & 15) * 8;
            *(u32x4*)(Bs + l * LDT + n8) = *(const u32x4*)(xbc + (size_t)(tok0 + l) * 1536 + 1024 + g * 128 + n8);
            *(u32x4*)(Cs + l * LDT + n8) = *(const u32x4*)(xbc + (size_t)(tok0 + l) * 1536 + 1280 + g * 128 + n8); }
        if (tid < 128) ssq[tid] = 0.f;
        __syncthreads();
        bf16x8 Cf[4];
#pragma unroll
        for (int ks = 0; ks < 4; ++ks) Cf[ks] = *(const bf16x8*)(Cs + (16 * w + fr) * LDT + 32 * ks + 8 * fq);
        f32x4 G[8];
#pragma unroll
        for (int j = 0; j < 8; ++j) { G[j] = (f32x4){0.f, 0.f, 0.f, 0.f};
            if (j <= w) {
#pragma unroll
                for (int ks = 0; ks < 4; ++ks) { const bf16x8 b = *(const bf16x8*)(Bs + (16 * j + fr) * LDT + 32 * ks + 8 * fq); G[j] = MFMA16(Cf[ks], b, G[j]); } } }
        for (int k = 0; k < 8; ++k) {
            const int hh = g * 8 + k; const float Dh = p.ssm_d[li * 16 + hh];
            __syncthreads();
            if (tid < 128) acs_s[tid] = acs[(size_t)(tok0 + tid) * 16 + hh];
#pragma unroll
            for (int i = 0; i < 2; ++i) { const int v = tid + i * NTHR, l = v >> 3, p8 = (v & 7) * 8;
                const float wl = dtb[(size_t)(tok0 + l) * 16 + hh];
                const u32x4 q = *(const u32x4*)(xbc + (size_t)(tok0 + l) * 1536 + hh * 64 + p8);
#pragma unroll
                for (int j = 0; j < 4; ++j) { Xt[(p8 + 2 * j) * LDT + l] = f2bf(bflo(q[j]) * wl); Xt[(p8 + 2 * j + 1) * LDT + l] = f2bf(bfhi(q[j]) * wl); } }
            __syncthreads();
            float al[4];
#pragma unroll
            for (int i = 0; i < 4; ++i) al[i] = acs_s[16 * w + 4 * fq + i];
#pragma unroll
            for (int j = 0; j < 8; ++j) {
                if (j <= (w | 1)) { const int s = 16 * j + fr; const float as_ = acs_s[s];
#pragma unroll
                    for (int i = 0; i < 4; ++i) { const int l = 16 * w + 4 * fq + i; const float m = (s <= l) ? G[j][i] * __expf(al[i] - as_) : 0.f; Ml[l * LDT + s] = f2bf(m); } } }
            f32x4 yd[4], yo[4];
#pragma unroll
            for (int j = 0; j < 4; ++j) { yd[j] = (f32x4){0.f, 0.f, 0.f, 0.f}; yo[j] = (f32x4){0.f, 0.f, 0.f, 0.f}; }
#pragma unroll
            for (int ks = 0; ks < 4; ++ks) {
                if (ks <= (w >> 1)) { const bf16x8 a = *(const bf16x8*)(Ml + (16 * w + fr) * LDT + 32 * ks + 8 * fq);
#pragma unroll
                    for (int j = 0; j < 4; ++j) { const bf16x8 b = *(const bf16x8*)(Xt + (16 * j + fr) * LDT + 32 * ks + 8 * fq); yd[j] = MFMA16(a, b, yd[j]); } } }
            const bf16_t* sp = st + ((size_t)bc * 16 + hh) * 8192;
#pragma unroll
            for (int ks = 0; ks < 4; ++ks)
#pragma unroll
                for (int j = 0; j < 4; ++j) { const bf16x8 b = *(const bf16x8*)(sp + (16 * j + fr) * 128 + 32 * ks + 8 * fq); yo[j] = MFMA16(Cf[ks], b, yo[j]); }
            float part[4] = {0.f, 0.f, 0.f, 0.f};
#pragma unroll
            for (int i = 0; i < 4; ++i) { const int l = 16 * w + 4 * fq + i; const float ea = __expf(al[i]);
#pragma unroll
                for (int j = 0; j < 4; ++j) { const int pc = hh * 64 + 16 * j + fr;
                    const float xv = bf2f(xbc[(size_t)(tok0 + l) * 1536 + pc]);
                    bf16_t* zp = ycat + (size_t)(tok0 + l) * 2048 + pc;
                    const float y = (yd[j][i] + ea * yo[j][i] + Dh * xv) * siluf_(bf2f(*zp));
                    part[i] += y * y; *zp = f2bf(y); } }
#pragma unroll
            for (int i = 0; i < 4; ++i) { float s = part[i]; s += __shfl_xor(s, 1); s += __shfl_xor(s, 2); s += __shfl_xor(s, 4); s += __shfl_xor(s, 8);
                if (fr == 0) ssq[16 * w + 4 * fq + i] += s; }
        }
        __threadfence(); __syncthreads(); __threadfence();
        { const f32x4 g0 = *(const f32x4*)(p.ssm_norm_g + li * 1024 + g * 512 + lane * 8), g1 = *(const f32x4*)(p.ssm_norm_g + li * 1024 + g * 512 + lane * 8 + 4);
          for (int rr = 0; rr < 16; ++rr) { const int l = 16 * w + rr; const float sc = rsqrtf(ssq[l] * (1.0f / 512.0f) + EPS);
            bf16_t* yp = ycat + (size_t)(tok0 + l) * 2048 + g * 512 + lane * 8;
            const u32x4 q = *(const u32x4*)yp; u32x4 o;
            o.x = cvt_pk_bf16(bflo(q.x) * sc * g0[0], bfhi(q.x) * sc * g0[1]); o.y = cvt_pk_bf16(bflo(q.y) * sc * g0[2], bfhi(q.y) * sc * g0[3]);
            o.z = cvt_pk_bf16(bflo(q.z) * sc * g1[0], bfhi(q.z) * sc * g1[1]); o.w = cvt_pk_bf16(bflo(q.w) * sc * g1[2], bfhi(q.w) * sc * g1[3]);
            *(u32x4*)yp = o; } }
    }
    __syncthreads();
}

DI void attn_phase(unsigned char* shm, const Params& p) {
    using bf = fa::bf16; char* lds = (char*)shm; float* ckl = (float*)(lds + fa::LDS_BYTES);
    unsigned char* ws = p.ws; const bf* Q = (const bf*)(ws + OFF_QKV); const bf* K = Q + (size_t)MT * 1024; const bf* V = K + (size_t)MT * 1024;
    bf* Y = (bf*)(ws + OFF_YCAT); const float* cum = (const float*)(ws + OFF_CUM);
    const int total = 512, stride = gridDim.x; int L = bidx(); if (L >= total) return;
    auto mkref = [&](int L_, int pass) { const int bh = L_ >> 3, x = L_ & 7, qb = pass ? 15 - x : x, b = bh >> 3, h = bh & 7;
        fa::BlockRef<bf, bf> r; r.Q = Q + ((size_t)bh * SEQ + (size_t)qb * 256) * 128; r.K = K + (size_t)bh * SEQ * 128; r.V = V + (size_t)bh * SEQ * 128;
        r.O = Y + ((size_t)(b * SEQ + qb * 256)) * 2048 + 1024 + h * 128; r.P0 = qb * 256; return r; };
    int pass = 0; fa::BlockRef<bf, bf> cur = mkref(L, 0);
    { const float* c = cum + (size_t)(L >> 3) * SEQ; for (int i = tidx(); i < cur.P0 + 256; i += NTHR) ckl[i] = c[i] * fa::BSC; }
    __syncthreads();
    fa::Seam<bf> S;
    fa::causal_swa_prime<bf, bf>(cur, fa::WINDOW, lds, S);
    for (;;) {
        const bool more_pass = pass == 0, more_item = L + stride < total, last = !more_pass && !more_item;
        int passn = pass + 1, Ln = L; if (!more_pass) { passn = 0; Ln = more_item ? L + stride : L; }
        const fa::BlockRef<bf, bf> nxt = last ? cur : mkref(Ln, passn);
        fa::causal_swa_block<bf, bf>(cur, nxt, fa::SKV, fa::WINDOW, lds, S, ckl);
        if (last) break;
        cur = nxt; pass = passn; L = Ln;
        { const float* c = cum + (size_t)(L >> 3) * SEQ; for (int i = tidx(); i < cur.P0 + 256; i += NTHR) ckl[i] = c[i] * fa::BSC; }
        __syncthreads();
    }
    asm volatile("s_waitcnt vmcnt(0)" ::: "memory");
    __syncthreads();
}
constexpr int LDF = 132;
DI void rec_gates_phase(unsigned char* shm, const Params& p, int ri) {
    unsigned char* ws = p.ws; const int tid = tidx(), lane = tid & 63, w = __builtin_amdgcn_readfirstlane(tid >> 6), fr = lane & 15, fq = lane >> 4;
    const bf16_t* xr = (const bf16_t*)(ws + OFF_YCAT) + (size_t)MT * 1024; const bf16_t* Wg = (const bf16_t*)(ws + OFF_WG);
    float* la = (float*)(ws + OFF_QKV); float* ub = la + (size_t)MT * 1024;
    bf16_t* Xa = (bf16_t*)shm;
    float* Xf = (float*)(shm + 128 * LDT * 2);
    const float* cw = p.rec_conv_w + (size_t)ri * 4 * 1024; const float* cb = p.rec_conv_b + (size_t)ri * 1024;
    for (int it = bidx(); it < 2048; it += gridDim.x) {
        const int nb = it & 7, rt = it >> 3, tok0 = rt * 128, ch0 = nb * 128;
        __syncthreads();
        { const int c8 = (tid & 15) * 8, c = ch0 + c8;
          float wv[4][8], bias[8];
#pragma unroll
          for (int k = 0; k < 4; ++k) { const f32x4 a = *(const f32x4*)(cw + k * 1024 + c), b2 = *(const f32x4*)(cw + k * 1024 + c + 4);
#pragma unroll
              for (int j = 0; j < 4; ++j) { wv[k][j] = a[j]; wv[k][4 + j] = b2[j]; } }
          { const f32x4 a = *(const f32x4*)(cb + c), b2 = *(const f32x4*)(cb + c + 4);
#pragma unroll
            for (int j = 0; j < 4; ++j) { bias[j] = a[j]; bias[4 + j] = b2[j]; } }
#pragma unroll
          for (int i = 0; i < 4; ++i) { const int l = (tid >> 4) + 32 * i, t = tok0 + l, s = t & (SEQ - 1);
              float y[8];
#pragma unroll
              for (int j = 0; j < 8; ++j) y[j] = bias[j];
#pragma unroll
              for (int k = 0; k < 4; ++k) { if (s - 3 + k >= 0) { const u32x4 q = *(const u32x4*)(xr + (size_t)(t - 3 + k) * 1024 + c);
#pragma unroll
                  for (int j = 0; j < 4; ++j) { y[2 * j] += wv[k][2 * j] * bflo(q[j]); y[2 * j + 1] += wv[k][2 * j + 1] * bfhi(q[j]); } } }
              u32x4 o; o.x = cvt_pk_bf16(y[0], y[1]); o.y = cvt_pk_bf16(y[2], y[3]); o.z = cvt_pk_bf16(y[4], y[5]); o.w = cvt_pk_bf16(y[6], y[7]);
              *(u32x4*)(Xa + l * LDT + c8) = o;
              *(f32x4*)(Xf + l * LDF + c8) = (f32x4){y[0], y[1], y[2], y[3]}; *(f32x4*)(Xf + l * LDF + c8 + 4) = (f32x4){y[4], y[5], y[6], y[7]}; } }
        __syncthreads();
        bf16x8 Af[4];
#pragma unroll
        for (int ks = 0; ks < 4; ++ks) Af[ks] = *(const bf16x8*)(Xa + (16 * w + fr) * LDT + 32 * ks + 8 * fq);
        const bf16_t* Wb = Wg + (size_t)nb * 256 * 128;
#pragma unroll 2
        for (int j = 0; j < 8; ++j) {
            f32x4 ar = (f32x4){0.f, 0.f, 0.f, 0.f}, ax = (f32x4){0.f, 0.f, 0.f, 0.f};
#pragma unroll
            for (int ks = 0; ks < 4; ++ks) { const bf16x8 ba = *(const bf16x8*)(Wb + (16 * j + fr) * 128 + 32 * ks + 8 * fq), bx = *(const bf16x8*)(Wb + (128 + 16 * j + fr) * 128 + 32 * ks + 8 * fq);
                ar = MFMA16(Af[ks], ba, ar); ax = MFMA16(Af[ks], bx, ax); }
            const int cl = 16 * j + fr, ch = ch0 + cl;
            const float ba_ = p.rec_b_a[ri * 1024 + ch], bx_ = p.rec_b_x[ri * 1024 + ch], lsl = 8.0f * logsigf_(p.rec_lambda[ri * 1024 + ch]);
#pragma unroll
            for (int i = 0; i < 4; ++i) { const int l = 16 * w + 4 * fq + i;
                const float r = sigmoidf_(ar[i] + ba_), ig = sigmoidf_(ax[i] + bx_), lg = lsl * r;
                const float u = sqrtf(fmaxf(-expm1f(2.0f * lg), 0.f)) * (ig * Xf[l * LDF + cl]);
                la[(size_t)(tok0 + l) * 1024 + ch] = lg; ub[(size_t)(tok0 + l) * 1024 + ch] = u; }
        }
    }
    __syncthreads();
}
DI void rec_local_phase(const Params& p) {
    unsigned char* ws = p.ws; const float* la = (const float*)(ws + OFF_QKV); const float* ub = la + (size_t)MT * 1024;
    float* RH = (float*)(ws + OFF_RH); float* RA = (float*)(ws + OFF_RA); const int c2 = tidx() * 2;
    for (int it = bidx(); it < 512; it += gridDim.x) {
        float h0 = 0.f, h1 = 0.f, a0 = 0.f, a1 = 0.f;
#pragma unroll 8
        for (int q = 0; q < 64; ++q) { const size_t o = (size_t)(it * 64 + q) * 1024 + c2;
            const float2 l2 = *(const float2*)(la + o), u2 = *(const float2*)(ub + o);
            h0 = __expf(l2.x) * h0 + u2.x; h1 = __expf(l2.y) * h1 + u2.y; a0 += l2.x; a1 += l2.y; }
        *(float2*)(RH + (size_t)it * 1024 + c2) = make_float2(h0, h1); *(float2*)(RA + (size_t)it * 1024 + c2) = make_float2(a0, a1);
    }
}
DI void rec_carry_phase(const Params& p) {
    unsigned char* ws = p.ws; const float* RH = (const float*)(ws + OFF_RH); const float* RA = (const float*)(ws + OFF_RA); float* RC = (float*)(ws + OFF_RC);
    for (int idx = bidx() * NTHR + tidx(); idx < 8192; idx += gridDim.x * NTHR) {
        const int b = idx >> 10, c = idx & 1023; float carry = 0.f;
        for (int z = 0; z < 64; ++z) { const size_t o = (size_t)(b * 64 + z) * 1024 + c; RC[o] = carry; carry = __expf(RA[o]) * carry + RH[o]; }
    }
}
DI void rec_final_phase(const Params& p) {
    unsigned char* ws = p.ws; const float* la = (const float*)(ws + OFF_QKV); const float* ub = la + (size_t)MT * 1024;
    const float* RC = (const float*)(ws + OFF_RC); bf16_t* gate = (bf16_t*)(ws + OFF_YCAT); const int c2 = tidx() * 2;
    for (int it = bidx(); it < 512; it += gridDim.x) {
        const float2 cr = *(const float2*)(RC + (size_t)it * 1024 + c2); float h0 = cr.x, h1 = cr.y;
#pragma unroll 8
        for (int q = 0; q < 64; ++q) { const size_t o = (size_t)(it * 64 + q) * 1024 + c2;
            const float2 l2 = *(const float2*)(la + o), u2 = *(const float2*)(ub + o); const unsigned gq = *(const unsigned*)(gate + o);
            h0 = __expf(l2.x) * h0 + u2.x; h1 = __expf(l2.y) * h1 + u2.y;
            *(unsigned*)(gate + o) = cvt_pk_bf16(h0 * bflo(gq), h1 * bfhi(gq)); }
    }
}
constexpr int STEPS = 13, NPHASE = 1 + 4 * STEPS;
DI void ffn_resnorm(const Params& p, int layer, int gi_post, float wgt, const float* gpre) {
    unsigned char* ws = p.ws;
    resnorm_phase(p.out, (const bf16_t*)(ws + OFF_XBCP), wgt, p.norm_g + ((size_t)layer * 6 + gi_post) * DM, gpre, p.out, (bf16_t*)(ws + OFF_XN));
}
DI void run_phase(unsigned char* shm, const Params& p, int ph) {
    unsigned char* ws = p.ws;
    if (ph == 0) { convert_weights(shm, p, 0); resnorm_phase(p.x, nullptr, 0.f, nullptr, p.norm_g, p.out, (bf16_t*)(ws + OFF_XN)); return; }
    const int layer = (ph - 1) / STEPS, st = (ph - 1) % STEPS, hyb = (layer & 1) == 0, mi = layer >> 1;
    const float* ng = p.norm_g + (size_t)layer * 6 * DM;
    switch (st) {
    case 0: case 10: { EpiSwiglu E; E.O = (bf16_t*)(ws + OFF_QKV);
        run_gemm(shm, (const bf16_t*)(ws + OFF_XN), (const bf16_t*)(ws + OFF_WFIN + (st ? SZ_WFIN : 0)), 5632, 1024, E); } break;
    case 1: case 11: { EpiPlain E; E.O = (bf16_t*)(ws + OFF_XBCP); E.ldc = 1024;
        run_gemm(shm, (const bf16_t*)(ws + OFF_QKV), (const bf16_t*)(ws + OFF_WFOUT + (st == 11 ? SZ_WFOUT : 0)), 1024, 2816, E); } break;
    case 2: ffn_resnorm(p, layer, 1, 0.5f, ng + 2 * DM); break;
    case 3:
        if (hyb) { EpiHyb E; E.ycat = (bf16_t*)(ws + OFF_YCAT); E.xbcp = (bf16_t*)(ws + OFF_XBCP); E.qkv = (bf16_t*)(ws + OFF_QKV); E.misc = (float*)(ws + OFF_MISC);
            run_gemm(shm, (const bf16_t*)(ws + OFF_XN), (const bf16_t*)(ws + OFF_WMIN), 5888, 1024, E); }
        else { EpiRec E; E.G = (bf16_t*)(ws + OFF_YCAT); E.X = (bf16_t*)(ws + OFF_YCAT) + (size_t)MT * 1024;
            run_gemm(shm, (const bf16_t*)(ws + OFF_XN), (const bf16_t*)(ws + OFF_WMIN), 2048, 1024, E); }
        break;
    case 4: if (hyb) hyb_prep_phase(shm, p, mi); else rec_gates_phase(shm, p, mi); break;
    case 5: if (hyb) ssd_states_phase(shm, p); else rec_local_phase(p); break;
    case 6: if (hyb) ssd_carry_phase(p); else rec_carry_phase(p); break;
    case 7: if (hyb) { attn_phase(shm, p); ssd_out_phase(shm, p, mi); } else rec_final_phase(p); break;
    case 8: { EpiPlain E; E.O = (bf16_t*)(ws + OFF_XBCP); E.ldc = 1024;
        if (hyb) run_gemm(shm, (const bf16_t*)(ws + OFF_YCAT), (const bf16_t*)(ws + OFF_WMOUT), 1024, 2048, E);
        else run_gemm(shm, (const bf16_t*)(ws + OFF_YCAT), (const bf16_t*)(ws + OFF_WMOUT), 1024, 1024, E); } break;
    case 9: ffn_resnorm(p, layer, 3, 1.0f, ng + 4 * DM); break;
    case 12: if (layer < 3) convert_weights(shm, p, layer + 1);
        ffn_resnorm(p, layer, 5, 0.5f, layer < 3 ? p.norm_g + (size_t)(layer + 1) * 6 * DM : nullptr); break;
    }
}
__global__ void __launch_bounds__(NTHR, 2) fwd_megakernel(Params p) {
    extern __shared__ __attribute__((aligned(16))) unsigned char shm[];
    cg::grid_group grid = cg::this_grid();
    for (int ph = p.ph_lo; ph < p.ph_hi; ++ph) {
        run_phase(shm, p, ph);
        if (ph + 1 < p.ph_hi) grid.sync();
    }
}

extern "C" void kernel_launch(void* const* d_in, const int* in_sizes, int n_in, void* d_out, int out_size, void* d_ws, size_t ws_size, hipStream_t stream) {
    static int grid = 0;
    if (grid == 0) {
        if (n_in != 22 || out_size != MT * DM || ws_size < WS_END) { fprintf(stderr, "kernel_launch: unexpected shapes (n_in %d out %d ws %zu need %zu)\n", n_in, out_size, ws_size, (size_t)WS_END); grid = -1; return; }
        int dev = 0, cus = 0, per_cu = 0;
        hipGetDevice(&dev); hipDeviceGetAttribute(&cus, hipDeviceAttributeMultiprocessorCount, dev);
        if (hipFuncSetAttribute((const void*)fwd_megakernel, hipFuncAttributeMaxDynamicSharedMemorySize, LDS_TOTAL) != hipSuccess) { fprintf(stderr, "kernel_launch: hipFuncSetAttribute failed\n"); grid = -1; return; }
        if (hipOccupancyMaxActiveBlocksPerMultiprocessor(&per_cu, (const void*)fwd_megakernel, NTHR, LDS_TOTAL) != hipSuccess || per_cu < 1) { fprintf(stderr, "kernel_launch: occupancy query says %d\n", per_cu); per_cu = 1; }
        (void)hipGetLastError();
        grid = cus * (per_cu > 1 ? 1 : per_cu);
        if (grid <= 0) grid = 256;
    }
    if (grid < 0) return;
    Params p{};
    const float** f = (const float**)&p;
    for (int i = 0; i < 22; ++i) f[i] = (const float*)d_in[i];
    p.out = (float*)d_out; p.ws = (unsigned char*)d_ws;
#if PER_PHASE_LAUNCH
    for (int ph = 0; ph < NPHASE; ++ph) { p.ph_lo = ph; p.ph_hi = ph + 1;
        hipLaunchKernelGGL(fwd_megakernel, dim3(grid), dim3(NTHR), LDS_TOTAL, stream, p); }
#else
    p.ph_lo = 0; p.ph_hi = NPHASE;
    void* args[] = {&p};
    hipError_t e = hipLaunchCooperativeKernel((const void*)fwd_megakernel, dim3(grid), dim3(NTHR), args, LDS_TOTAL, stream);
    if (e != hipSuccess) fprintf(stderr, "cooperative launch failed: %s (grid %d)\n", hipGetErrorString(e), grid);
#endif
}
```

```cpp
#include <hip/hip_runtime.h>
#include <hip/hip_bf16.h>
#include <hip/hip_cooperative_groups.h>
#include <cstdio>
#include <cstdint>
namespace cg = cooperative_groups;
#ifndef REP_MASK
#define REP_MASK 0
#endif
#ifndef PROBE_CAT
#define PROBE_CAT 0
#endif
#ifndef PER_PHASE_LAUNCH
#define PER_PHASE_LAUNCH 0
#endif
__device__ __forceinline__ int tidx() { int t = threadIdx.x; asm volatile("" : "+v"(t)); return t; }
__device__ __forceinline__ int bidx() { int t = blockIdx.x; asm volatile("" : "+s"(t)); return t; }
#define XB_TMO      128
#define XB_XCNT(j)  (256  + 64 * (j))
#define XB_XSUB(j)  (1280 + 64 * (j))
#define XB_XGEN(j)  (2304 + 64 * (j))
#define XB_TOP      3328
#define XB_TOPGEN   3392
#define XCD_BAR_WORDS 3456
#define XB_SPIN_CAP (1u << 18)
#define LAS __attribute__((address_space(3)))

__device__ __forceinline__ unsigned xb_ld(unsigned* p)              { return __hip_atomic_load(p, __ATOMIC_RELAXED, __HIP_MEMORY_SCOPE_AGENT); }
__device__ __forceinline__ unsigned xb_add(unsigned* p, unsigned v) { return __hip_atomic_fetch_add(p, v, __ATOMIC_RELAXED, __HIP_MEMORY_SCOPE_AGENT); }
__device__ __forceinline__ unsigned xb_xcc_id() { return (unsigned)__builtin_amdgcn_s_getreg((3 << 11) | 20) & 0xFu; }
#define XB_SPIN(cond, bar) do { unsigned _sp = 0; while (cond) { __builtin_amdgcn_s_sleep(1); \
    if ((++_sp & 255u) == 0u) { if (xb_ld(&(bar)[XB_TMO])) break; if (_sp > XB_SPIN_CAP) { atomicAdd(&(bar)[XB_TMO], 1u); break; } } } } while (0)

struct XcdBarrier {
    unsigned* bar; unsigned x;
    volatile LAS unsigned* st;
};

__device__ __forceinline__ XcdBarrier xcd_barrier_post(unsigned* bar, volatile LAS unsigned* st) {
    XcdBarrier b; b.bar = bar; b.x = xb_xcc_id(); b.st = st;
    if (tidx() == 0) (void)xb_add(&bar[XB_XCNT(b.x)], 1u);
    return b;
}
__device__ __forceinline__ void xcd_barrier_complete(unsigned* bar, unsigned x, unsigned& nloc, unsigned& nx) {
    const unsigned G = gridDim.x * gridDim.y * gridDim.z;
    unsigned sum, cnt, mine, sp = 0u;
    for (;;) {
        sum = 0u; cnt = 0u; mine = 0u;
#pragma unroll
        for (unsigned j = 0; j < 16; ++j) { const unsigned c = xb_ld(&bar[XB_XCNT(j)]); sum += c; cnt += (c > 0u) ? 1u : 0u; mine = (j == x) ? c : mine; }
        if (sum == G) break;
        __builtin_amdgcn_s_sleep(1);
        if ((++sp & 255u) == 0u) { if (xb_ld(&bar[XB_TMO])) break; if (sp > XB_SPIN_CAP) { atomicAdd(&bar[XB_TMO], 1u); break; } }
    }
    nloc = mine > 0u ? mine : 1u; nx = cnt > 0u ? cnt : 1u;
}

__device__ __forceinline__ void xcd_barrier(const XcdBarrier& b) {
    asm volatile("s_waitcnt vmcnt(0)" ::: "memory");
    __syncthreads();
    if (tidx() == 0) {
        unsigned* bar = b.bar;
        __builtin_amdgcn_s_waitcnt(0);
        unsigned nloc = b.st[0], nx = b.st[1];
        if (nloc == 0u) { xcd_barrier_complete(bar, b.x, nloc, nx); b.st[0] = nloc; b.st[1] = nx; }
        const unsigned old = xb_add(&bar[XB_XSUB(b.x)], 1u);
        const unsigned gen = old / nloc;
        if (old + 1u == (gen + 1u) * nloc) {
            __builtin_amdgcn_fence(__ATOMIC_RELEASE, "agent");
            asm volatile("s_waitcnt vmcnt(0)" ::: "memory");
            const unsigned og = xb_add(&bar[XB_TOP], 1u);
            const unsigned tg = og / nx;
            if (og + 1u == (tg + 1u) * nx) xb_add(&bar[XB_TOPGEN], 1u);
            else XB_SPIN(xb_ld(&bar[XB_TOPGEN]) == tg, bar);
            __builtin_amdgcn_fence(__ATOMIC_ACQUIRE, "agent");
            xb_add(&bar[XB_XGEN(b.x)], 1u);
            asm volatile("s_waitcnt vmcnt(0)" ::: "memory");
        } else {
            XB_SPIN(xb_ld(&bar[XB_XGEN(b.x)]) == gen, bar);
            __builtin_amdgcn_fence(__ATOMIC_ACQUIRE, "agent");
            asm volatile("s_waitcnt vmcnt(0)" ::: "memory");
        }
    }
    __syncthreads();
}
namespace pg8 {
#define PG8_LAS __attribute__((address_space(3)))
typedef unsigned short bf16_t;
typedef short bf16x8 __attribute__((ext_vector_type(8)));
typedef float f32x4 __attribute__((ext_vector_type(4)));
typedef unsigned u32x4 __attribute__((ext_vector_type(4)));
constexpr int BM = 256, BK = 64, HALF = 128, HTB = HALF * BK * 2  , STAGE_BYTES = 8 * HTB, NXCD = 8, WGM = 4;

__host__ __device__ __forceinline__ int lds_byte(int r, int c) { const int st = (r >> 4) * 2 + (c >> 5), rr = r & 15, cc = c & 31, ob = rr * 64 + cc * 2; return st * 1024 + (ob ^ (((ob >> 9) & 1) << 5)); }
__host__ __device__ __forceinline__ void stage_rc(int b, int& R, int& C) { const int st = b / 1024, sb = b % 1024, swz = sb ^ (((sb >> 9) & 1) << 5); R = (st >> 1) * 16 + swz / 64; C = (st & 1) * 32 + (swz % 64) / 2; }
__host__ __device__ __forceinline__ int perm32(int rho) { const int n = rho >> 4, i = rho & 15; return 8 * (i >> 2) + 4 * n + (i & 3); }

struct Unit { int pm, pn; };
struct Gemm { const bf16_t* A; const bf16_t* Bt; int M, N, K; };

struct StaticOrder {
    int nM, nN, nwg, G, c;
    __host__ __device__ void init(int M, int N, int G_, int c_) { nM = M / BM; nN = N / BM; nwg = nM * nN; G = G_; c = c_; }
    __host__ __device__ bool next(int i, Unit& u) const {
        const long L = (long)i * G + c; if (L >= nwg) return false;
        int wgid = (int)L; { const int q = nwg / NXCD, r = nwg % NXCD, xcd = wgid % NXCD, off = wgid / NXCD; wgid = (xcd < r ? xcd * (q + 1) : r * (q + 1) + (xcd - r) * q) + off; }
        const int nig = WGM * nN, gid = wgid / nig, fm = gid * WGM, gsz = (nM - fm) < WGM ? (nM - fm) : WGM;
        u.pm = fm + ((wgid % nig) % gsz); u.pn = (wgid % nig) / gsz; return true;
    }
    __device__ __forceinline__ void a_ready(const Unit&) const {}
    __device__ __forceinline__ void done(const Unit&) const {}
};
typedef float f32x2c __attribute__((ext_vector_type(2)));
typedef __bf16 bf16x2c __attribute__((ext_vector_type(2)));
__device__ __forceinline__ unsigned cvt_pk_bf16(float lo, float hi) { const f32x2c v = {lo, hi}; return __builtin_bit_cast(unsigned, __builtin_convertvector(v, bf16x2c)); }

template <class Epi, class Sched, bool STAMP = false>
__device__ __forceinline__ void gemm_phase(PG8_LAS unsigned char* lds, const Gemm g, const Sched& S, const Epi& E, unsigned long long* stamps) {
    const int tid = tidx(), wid = __builtin_amdgcn_readfirstlane(tid >> 6), lane = tid & 63, wr = wid >> 2, wc = wid & 3, fr = lane & 15, fq = lane >> 4;
    const int K = g.K, nt = K / BK;
    int ts_lo = 0, ts_hi = 0, nts = 0; const unsigned long long rt_entry = STAMP ? (unsigned long long)wall_clock64() : 0ull;
#define PG8_STAMP() do { if (STAMP && wid == 0 && nts < 64) { const unsigned long long _c = (unsigned long long)clock64(); \
        ts_lo = (lane == nts) ? (int)(unsigned)_c : ts_lo; ts_hi = (lane == nts) ? (int)(unsigned)(_c >> 32) : ts_hi; ++nts; } } while (0)
    PG8_STAMP();
    unsigned voffA[2], voffB[2];
#pragma unroll
    for (int i = 0; i < 2; ++i) { int R, C; stage_rc(tid * 16 + i * 8192, R, C); const int Rb = Epi::PERM ? ((R & ~31) + perm32(R & 31)) : R;
        voffA[i] = (unsigned)(R * K + C) * 2u; voffB[i] = (unsigned)(Rb * K + C) * 2u; }
    const size_t kstep = (size_t)(BK * 2);
    const size_t hstep = (size_t)HALF * K * 2;
    const size_t tstep = 2 * hstep;
    const unsigned ldsw = (unsigned)wid * 1024u;
    const int aoff = lds_byte(wr * 64 + fr, fq * 8), boff = lds_byte(wc * 32 + fr, fq * 8);
#define PG8_SA(b, h) (((b) * 2 + (h)) * HTB)
#define PG8_SB(b, h) ((4 + (b) * 2 + (h)) * HTB)
#define PG8_STAGE(bufoff, gbase, voff) do { _Pragma("unroll") for (int _i = 0; _i < 2; ++_i) \
        __builtin_amdgcn_global_load_lds((const unsigned*)((const char*)(gbase) + (voff)[_i]), (PG8_LAS unsigned*)(lds + (bufoff) + ldsw + _i * 8192), 16, 0, 0); } while (0)
#define PG8_LDA(dst, b, h) do { _Pragma("unroll") for (int m = 0; m < 4; ++m) _Pragma("unroll") for (int k = 0; k < 2; ++k) dst[m][k] = *(const PG8_LAS bf16x8*)(lds + PG8_SA(b, h) + aoff + m * 2048 + k * 1024); } while (0)
#define PG8_LDB(dst, b, h) do { _Pragma("unroll") for (int n = 0; n < 2; ++n) _Pragma("unroll") for (int k = 0; k < 2; ++k) dst[n][k] = *(const PG8_LAS bf16x8*)(lds + PG8_SB(b, h) + boff + n * 2048 + k * 1024); } while (0)
#define PG8_MMA(ai, bj, At, Bt) do { __builtin_amdgcn_s_setprio(1); _Pragma("unroll") for (int m = 0; m < 4; ++m) _Pragma("unroll") for (int n = 0; n < 2; ++n) _Pragma("unroll") for (int k = 0; k < 2; ++k) \
        acc[ai][bj][m][n] = __builtin_amdgcn_mfma_f32_16x16x32_bf16(Bt[n][k], At[m][k], acc[ai][bj][m][n], 0, 0, 0); __builtin_amdgcn_s_setprio(0); } while (0)
#define PG8_WAIT_V(n) asm volatile("s_waitcnt vmcnt(" #n ")" ::: "memory")
#define PG8_WAIT_L(n) asm volatile("s_waitcnt lgkmcnt(" #n ")" ::: "memory")
#define PG8_BAR __builtin_amdgcn_s_barrier()
#define PG8_SCHED __builtin_amdgcn_sched_barrier(0)
    Unit cur, nxt; int ui = 0;
    if (!S.next(0, cur)) return;
    f32x4 acc[2][2][4][2];
#pragma unroll
    for (int a = 0; a < 2; ++a)
#pragma unroll
        for (int b = 0; b < 2; ++b)
#pragma unroll
            for (int m = 0; m < 4; ++m)
#pragma unroll
                for (int n = 0; n < 2; ++n) acc[a][b][m][n] = (f32x4){0.f, 0.f, 0.f, 0.f};
    bf16x8 At[4][2], B0[2][2], B1[2][2];
    const char* cA = (const char*)g.A + (size_t)cur.pm * tstep; const char* cB = (const char*)g.Bt + (size_t)cur.pn * tstep;
    S.a_ready(cur);
    PG8_STAGE(PG8_SB(0, 0), cB, voffB); PG8_STAGE(PG8_SA(0, 0), cA, voffA); PG8_STAGE(PG8_SB(0, 1), cB + hstep, voffB); PG8_STAGE(PG8_SA(0, 1), cA + hstep, voffA);
    if (wr == 1) PG8_BAR;
    PG8_WAIT_V(4); PG8_BAR;
    PG8_STAGE(PG8_SB(1, 0), cB + kstep, voffB); PG8_STAGE(PG8_SA(1, 0), cA + kstep, voffA); PG8_STAGE(PG8_SB(1, 1), cB + hstep + kstep, voffB);
    PG8_WAIT_V(6); PG8_BAR;
    PG8_STAMP();
    for (;;) {
        const bool has_next = S.next(ui + 1, nxt);
        const char* nA = has_next ? (const char*)g.A + (size_t)nxt.pm * tstep : cA; const char* nB = has_next ? (const char*)g.Bt + (size_t)nxt.pn * tstep : cB;
        for (int t = 0; t < nt; t += 2) {
            const bool last = (t == nt - 2);
            const char* a1 = cA + (size_t)(t + 1) * kstep;
            const char* a2 = last ? nA : cA + (size_t)(t + 2) * kstep; const char* b2 = last ? nB : cB + (size_t)(t + 2) * kstep;
            const char* a3 = a2 + kstep; const char* b3 = b2 + kstep;
            if (last && has_next) S.a_ready(nxt);
            PG8_LDB(B0, 0, 0); PG8_SCHED; PG8_LDA(At, 0, 0); PG8_STAGE(PG8_SA(1, 1), a1 + hstep, voffA);
            PG8_WAIT_L(8); PG8_BAR; PG8_WAIT_L(0); PG8_MMA(0, 0, At, B0); PG8_BAR; PG8_SCHED;
            PG8_LDB(B1, 0, 1); PG8_STAGE(PG8_SB(0, 0), b2, voffB);
            PG8_BAR; PG8_WAIT_L(0); PG8_MMA(0, 1, At, B1); PG8_BAR;
            PG8_LDA(At, 0, 1); PG8_STAGE(PG8_SA(0, 0), a2, voffA);
            PG8_BAR; PG8_WAIT_L(0); PG8_MMA(1, 0, At, B0); PG8_BAR; PG8_SCHED;
            PG8_STAGE(PG8_SB(0, 1), b2 + hstep, voffB);
            PG8_WAIT_V(6); PG8_BAR; PG8_MMA(1, 1, At, B1); PG8_BAR;
            PG8_LDB(B0, 1, 0); PG8_SCHED; PG8_LDA(At, 1, 0); PG8_STAGE(PG8_SA(0, 1), a2 + hstep, voffA);
            PG8_WAIT_L(8); PG8_BAR; PG8_WAIT_L(0); PG8_MMA(0, 0, At, B0); PG8_BAR; PG8_SCHED;
            PG8_LDB(B1, 1, 1); PG8_STAGE(PG8_SB(1, 0), b3, voffB);
            PG8_BAR; PG8_WAIT_L(0); PG8_MMA(0, 1, At, B1); PG8_BAR;
            PG8_LDA(At, 1, 1); PG8_STAGE(PG8_SA(1, 0), a3, voffA);
            PG8_BAR; PG8_WAIT_L(0); PG8_MMA(1, 0, At, B0); PG8_BAR; PG8_SCHED;
            PG8_STAGE(PG8_SB(1, 1), b3 + hstep, voffB);
            PG8_WAIT_V(6); PG8_BAR; PG8_MMA(1, 1, At, B1); PG8_BAR;
        }
        PG8_STAMP();
        if constexpr (!Epi::AFTER_DRAIN) { E(acc, cur, wr, wc, fr, fq); S.done(cur); }
        PG8_STAMP();
        if (!has_next) break;
#pragma unroll
        for (int a = 0; a < 2; ++a)
#pragma unroll
            for (int b = 0; b < 2; ++b)
#pragma unroll
                for (int m = 0; m < 4; ++m)
#pragma unroll
                    for (int n = 0; n < 2; ++n) acc[a][b][m][n] = (f32x4){0.f, 0.f, 0.f, 0.f};
        cur = nxt; cA = nA; cB = nB; ++ui;
    }
    PG8_WAIT_V(0);
    if (wr == 0) PG8_BAR;
    PG8_BAR;
    if constexpr (Epi::AFTER_DRAIN) { E.fused(acc, cur, wr, wc, fr, fq, lds, wid, lane); S.done(cur); }
    PG8_STAMP();
    if (STAMP && wid == 0) { stamps[lane] = lane < nts ? (((unsigned long long)(unsigned)ts_hi << 32) | (unsigned)ts_lo) : 0ull;
        if (lane == 62) stamps[62] = rt_entry; if (lane == 63) stamps[63] = (unsigned long long)wall_clock64(); }
#undef PG8_STAMP
#undef PG8_SA
#undef PG8_SB
#undef PG8_STAGE
#undef PG8_LDA
#undef PG8_LDB
#undef PG8_MMA
#undef PG8_WAIT_V
#undef PG8_WAIT_L
#undef PG8_BAR
#undef PG8_SCHED
}
}
namespace fa {
using TIN = __hip_bfloat16; using TOUT = __hip_bfloat16;
constexpr int B = 8, H = 8, HKV = 8, SQ = 4096, SKV = 4096, D = 128;
constexpr int QOFF = 0; constexpr int WINDOW = SKV; constexpr float THR = 8.f;
constexpr bool WSKIP = false;
constexpr int OSTR = 2048;
constexpr float BSC = 11.313708498984761f;
constexpr float SCALE = 0.08838834764831845f;
constexpr int NW = 8, QBLK = 32, KVBLK = 64, QB = NW * QBLK;
constexpr int SHM_V = KVBLK * D * 2, SHM_K = KVBLK * D * 2;
constexpr int LDS_BYTES = 2 * SHM_V + 2 * SHM_K + NW * 64 * 4;
static_assert(D == 128 && SQ % QB == 0 && SKV % KVBLK == 0 && H % HKV == 0 && QOFF >= 0 && QOFF + SQ <= SKV && WINDOW >= 1, "geometry");

using bf16 = __hip_bfloat16;
typedef short bf16x8 __attribute__((ext_vector_type(8)));
typedef short s16x4 __attribute__((ext_vector_type(4)));
typedef float f32x16 __attribute__((ext_vector_type(16)));
typedef float f32x4 __attribute__((ext_vector_type(4)));
typedef unsigned u32x4 __attribute__((ext_vector_type(4)));
template <class A, class Bt> struct same_t { static constexpr bool v = false; };
template <class A> struct same_t<A, A> { static constexpr bool v = true; };

#define KSWZ(row, colB) ((row) * 256 + ((colB) ^ (((row) & 7) << 4)))
#define SBAR() __builtin_amdgcn_sched_barrier(0)
__device__ __forceinline__ int v_st(int k, int c) { const int kk = (k & ~0xC) | ((k & 4) << 1) | ((k & 8) >> 1); return ((kk >> 3) * 4 + (c >> 5)) * 512 + ((kk & 7) * 32 + (c & 31)) * 2; }
__device__ __forceinline__ int v_rd_base(int lane) { return ((lane & 3) << 3) | (((lane >> 2) & 3) << 6) | (((lane >> 4) & 1) << 5) | (((lane >> 5) & 1) << 8); }
constexpr int v_rd_off(int d0, int ks, int half) { return d0 * 512 + ks * 4096 + half * 2048; }
__device__ __forceinline__ int crow(int r, int hi) { return (r & 3) + 8 * (r >> 2) + 4 * hi; }
__device__ __forceinline__ unsigned cvtpk(float lo, float hi) {
    unsigned r; asm volatile("v_cvt_pk_bf16_f32 %0, %1, %2" : "=v"(r) : "v"(lo), "v"(hi)); return r;
}
__device__ __forceinline__ bf16x8 pack8(f32x4 a, f32x4 b) {
    u32x4 w = {cvtpk(a[0], a[1]), cvtpk(a[2], a[3]), cvtpk(b[0], b[1]), cvtpk(b[2], b[3])};
    return *reinterpret_cast<bf16x8*>(&w);
}
template <class T> __device__ __forceinline__ bf16x8 load8(const T* p) {
    if constexpr (same_t<T, float>::v) { return pack8(*(const f32x4*)p, *(const f32x4*)(p + 4)); }
    else { return *reinterpret_cast<const bf16x8*>(p); }
}
__device__ __forceinline__ void mask_tile(f32x16& p0, f32x16& p1, int dq, unsigned W) {
    const float NEG = -__builtin_inff();
#pragma unroll
    for (int r = 0; r < 16; ++r) {
        const int c = (r & 3) + 8 * (r >> 2);
        if ((unsigned)(dq - c) >= W) p0[r] = NEG;
        if ((unsigned)(dq - c - 32) >= W) p1[r] = NEG;
    }
}
__device__ __forceinline__ void partialSM(f32x16& p0, f32x16& p1, float& m_reg, float& mn, float& alpha) {
    float pmax = p0[0]; for (int r = 1; r < 16; ++r) pmax = fmaxf(pmax, p0[r]); for (int r = 0; r < 16; ++r) pmax = fmaxf(pmax, p1[r]);
    { auto rr = __builtin_amdgcn_permlane32_swap(__float_as_uint(pmax), __float_as_uint(pmax), false, false);
      pmax = fmaxf(__uint_as_float(rr[0]), __uint_as_float(rr[1])); }
    constexpr float C2 = 1.4426950408889634f * SCALE;
    if (__builtin_expect(__all((pmax - m_reg) * SCALE <= THR), 1)) { mn = m_reg; alpha = 1.f; }
    else { mn = fmaxf(m_reg, pmax); alpha = __builtin_amdgcn_exp2f((m_reg - mn) * C2); m_reg = mn; }
    const float mnL = -mn * C2;
    for (int r = 0; r < 16; ++r) p0[r] = fmaf(p0[r], C2, mnL); for (int r = 0; r < 16; ++r) p1[r] = fmaf(p1[r], C2, mnL);
    for (int r = 0; r < 16; ++r) p0[r] = __builtin_amdgcn_exp2f(p0[r]);
}
__device__ __forceinline__ void finishSM(f32x16& p0, f32x16& p1, float alpha, float& l_reg, bf16x8& pa0, bf16x8& pa1, bf16x8& pa2, bf16x8& pa3) {
    for (int r = 0; r < 16; ++r) p1[r] = __builtin_amdgcn_exp2f(p1[r]);
    float ps = 0; for (int r = 0; r < 16; ++r) ps += p0[r]; for (int r = 0; r < 16; ++r) ps += p1[r];
    { auto rr = __builtin_amdgcn_permlane32_swap(__float_as_uint(ps), __float_as_uint(ps), false, false);
      ps = __uint_as_float(rr[0]) + __uint_as_float(rr[1]); }
    l_reg = l_reg * alpha + ps;
#define PK4(P, B_, OUT) do { unsigned a0 = cvtpk(P[B_+0], P[B_+1]), a1 = cvtpk(P[B_+2], P[B_+3]);                          \
        unsigned b0 = cvtpk(P[B_+4], P[B_+5]), b1 = cvtpk(P[B_+6], P[B_+7]);                                             \
        auto r0 = __builtin_amdgcn_permlane32_swap(a0, b0, false, false); auto r1 = __builtin_amdgcn_permlane32_swap(a1, b1, false, false); \
        u32x4 w = {r0[0], r1[0], r0[1], r1[1]}; OUT = *reinterpret_cast<bf16x8*>(&w); } while (0)
    PK4(p0, 0, pa0); PK4(p0, 8, pa1); PK4(p1, 0, pa2); PK4(p1, 8, pa3);
#undef PK4
}
template <int KB, bool SK>
__device__ __forceinline__ void qkt(f32x16& p0, f32x16& p1, const char* K_lds, int r32, int hi, const bf16x8* qr, bool act, const float* cb) {
    if (SK && !act) { const float NEG = -__builtin_inff();
#pragma unroll
        for (int r = 0; r < 16; ++r) { p0[r] = NEG; p1[r] = NEG; } return; }
#pragma unroll
    for (int r4 = 0; r4 < 4; ++r4) { const f32x4 c0_ = *(const f32x4*)(cb + 8 * r4), c1_ = *(const f32x4*)(cb + 32 + 8 * r4);
#pragma unroll
        for (int i_ = 0; i_ < 4; ++i_) { p0[4 * r4 + i_] = c0_[i_]; p1[4 * r4 + i_] = c1_[i_]; } }
    const char* kb[4];
#pragma unroll
    for (int dd = 0; dd < 4; ++dd) kb[dd] = K_lds + KB * SHM_K + KSWZ(r32, (dd * 16 + hi * 8) * 2);
#pragma unroll
    for (int d0 = 0; d0 < 8; ++d0) { const char* a = kb[d0 & 3] + (d0 >> 2) * 128;
        bf16x8 b0 = *reinterpret_cast<const bf16x8*>(a);
        bf16x8 b1 = *reinterpret_cast<const bf16x8*>(a + 32 * 256);
        p0 = __builtin_amdgcn_mfma_f32_32x32x16_bf16(b0, qr[d0], p0, 0, 0, 0);
        p1 = __builtin_amdgcn_mfma_f32_32x32x16_bf16(b1, qr[d0], p1, 0, 0, 0); }
}
template <int VB, bool SK>
__device__ __forceinline__ void pv_tile(f32x16* o, int vb0, bf16x8 pa0, bf16x8 pa1, bf16x8 pa2, bf16x8 pa3, bool act) {
    if (SK && !act) return;
#define TRRD(dst, off) asm volatile("ds_read_b64_tr_b16 %0, %1 offset:%2" : "=&v"(dst) : "v"(vb0), "i"(off) : "memory")
#define PV_D0(d0) do { s16x4 l0, l1, l2, l3, h0, h1, h2, h3; constexpr int b_ = VB * SHM_V + v_rd_off(d0, 0, 0);     \
        TRRD(l0, b_); TRRD(h0, b_ + 2048); TRRD(l1, b_ + 4096); TRRD(h1, b_ + 6144); TRRD(l2, b_ + 8192); TRRD(h2, b_ + 10240); TRRD(l3, b_ + 12288); TRRD(h3, b_ + 14336); \
        asm volatile("s_waitcnt lgkmcnt(0)" ::: "memory"); SBAR();                 \
        o[d0] = __builtin_amdgcn_mfma_f32_32x32x16_bf16(pa0, (bf16x8){l0[0], l0[1], l0[2], l0[3], h0[0], h0[1], h0[2], h0[3]}, o[d0], 0, 0, 0);   \
        o[d0] = __builtin_amdgcn_mfma_f32_32x32x16_bf16(pa1, (bf16x8){l1[0], l1[1], l1[2], l1[3], h1[0], h1[1], h1[2], h1[3]}, o[d0], 0, 0, 0);   \
        o[d0] = __builtin_amdgcn_mfma_f32_32x32x16_bf16(pa2, (bf16x8){l2[0], l2[1], l2[2], l2[3], h2[0], h2[1], h2[2], h2[3]}, o[d0], 0, 0, 0);   \
        o[d0] = __builtin_amdgcn_mfma_f32_32x32x16_bf16(pa3, (bf16x8){l3[0], l3[1], l3[2], l3[3], h3[0], h3[1], h3[2], h3[3]}, o[d0], 0, 0, 0); } while (0)
    PV_D0(0); PV_D0(1); PV_D0(2); PV_D0(3);
#undef PV_D0
#undef TRRD
}

template <class TIn, class TOut> struct BlockRef { const TIn* Q; const TIn* K; const TIn* V; TOut* O; int P0; };
template <class TIn> struct Seam {
    bf16x8 qr[8];
    bf16x8 st_v0, st_v1, st_k0, st_k1; f32x4 sf0, sf1, sf2, sf3;
    f32x4 tq[16];
};
__device__ __forceinline__ int swa_jlo(int P0, int W) { const int lowk = P0 - W + 1; return lowk > 0 ? lowk / KVBLK : 0; }
#define ROW(p, k0, rr) ((p) + (size_t)((k0) + (rr)) * D + sc)
#define VMW() asm volatile("s_waitcnt vmcnt(0)" ::: "memory")
#define VMWN(n) asm volatile("s_waitcnt vmcnt(%0)" :: "i"(n) : "memory")
#define SLOAD_H(Kp, Vp, k0) do { S.st_v0 = load8<TIn>(ROW(Vp, k0, sr)); S.st_v1 = load8<TIn>(ROW(Vp, k0, 32 + sr));              \
                         S.st_k0 = load8<TIn>(ROW(Kp, k0, sr)); S.st_k1 = load8<TIn>(ROW(Kp, k0, 32 + sr)); } while (0)
#define SWRITE_HK(bf) do { *(bf16x8*)(K_lds + (bf) * SHM_K + kws) = S.st_k0; *(bf16x8*)(K_lds + (bf) * SHM_K + kws + 32 * 256) = S.st_k1; } while (0)
#define SWRITE_HV(bf) do { *(bf16x8*)(V_lds + (bf) * SHM_V + vst0) = S.st_v0; *(bf16x8*)(V_lds + (bf) * SHM_V + vst1) = S.st_v1; } while (0)
#define SWRITE_H(bf) do { SWRITE_HV(bf); SWRITE_HK(bf); } while (0)
#define SLOAD_F(p, k0) do { S.sf0 = *(const f32x4*)ROW(p, k0, sr); S.sf1 = *(const f32x4*)(ROW(p, k0, sr) + 4);                \
                            S.sf2 = *(const f32x4*)ROW(p, k0, 32 + sr); S.sf3 = *(const f32x4*)(ROW(p, k0, 32 + sr) + 4); } while (0)
#define SWRITE_KF(bf) do { *(bf16x8*)(K_lds + (bf) * SHM_K + kws) = pack8(S.sf0, S.sf1); *(bf16x8*)(K_lds + (bf) * SHM_K + kws + 32 * 256) = pack8(S.sf2, S.sf3); } while (0)
#define SWRITE_VF(bf) do { *(bf16x8*)(V_lds + (bf) * SHM_V + vst0) = pack8(S.sf0, S.sf1); *(bf16x8*)(V_lds + (bf) * SHM_V + vst1) = pack8(S.sf2, S.sf3); } while (0)
template <class TIn, class TOut>
__device__ __forceinline__ void causal_swa_prime(const BlockRef<TIn, TOut>& cur, int W, char* lds, Seam<TIn>& S) {
    constexpr bool F32 = same_t<TIn, float>::v;
    const int tid = tidx(), wid = __builtin_amdgcn_readfirstlane(tid >> 6), lane = tid & 63, r32 = lane & 31, hi = lane >> 5;
    const int sr = tid >> 4, sc = (tid & 15) * 8, kws = KSWZ(sr, sc * 2); char* K_lds = lds + 2 * SHM_V;
    const int kb0 = swa_jlo(cur.P0, W) * KVBLK;
    for (int d0 = 0; d0 < 8; ++d0) S.qr[d0] = load8<TIn>(cur.Q + (size_t)(wid * QBLK + r32) * D + d0 * 16 + hi * 8);
    if constexpr (F32) { SLOAD_F((const float*)cur.K, kb0); VMW(); SWRITE_KF(0); SBAR(); SLOAD_F((const float*)cur.V, kb0); }
    else { SLOAD_H(cur.K, cur.V, kb0); VMW(); SWRITE_HK(0); }
    __syncthreads();
}
template <class TIn, class TOut>
__device__ __forceinline__ void causal_swa_block(const BlockRef<TIn, TOut>& cur, const BlockRef<TIn, TOut>& nxt, int skv, int W, char* lds, Seam<TIn>& S, const float* ckl) {
    constexpr bool F32 = same_t<TIn, float>::v;
    const int tid = tidx(), wid = __builtin_amdgcn_readfirstlane(tid >> 6), lane = tid & 63, r32 = lane & 31, hi = lane >> 5;
    const int j_lo = swa_jlo(cur.P0, W);
    int j_hi = (cur.P0 + QB - 1) / KVBLK + 1; if (j_hi > skv / KVBLK) j_hi = skv / KVBLK;
    const int NT = j_hi - j_lo;
    const int kbn = swa_jlo(nxt.P0, W) * KVBLK;
    const int qlo = cur.P0 + wid * QBLK, qm = qlo + r32 - 4 * hi;
    char* V_lds = lds; char* K_lds = lds + 2 * SHM_V;
    float* ws = (float*)(lds + 2 * SHM_V + 2 * SHM_K) + wid * 64; float* li_l = ws, * al_l = ws + 32;
    float m_reg = -1e30f, l_reg = 0; f32x16 o[4] = {};
    const int sr = tid >> 4, sc = (tid & 15) * 8, vst0 = v_st(sr, sc), vst1 = v_st(32 + sr, sc), kws = KSWZ(sr, sc * 2);
    const int vb0 = (int)(uintptr_t)V_lds + v_rd_base(lane);
    const TIn* Kh = cur.K; const TIn* Vh = cur.V;
#define RESC(a) do { if (__any((a) < 1.f)) { if (hi == 0) al_l[r32] = (a); asm volatile("s_waitcnt lgkmcnt(0)" ::: "memory");              \
                     for (int d_ = 0; d_ < 4; ++d_) for (int r = 0; r < 16; ++r) o[d_][r] *= al_l[crow(r, hi)]; } } while (0)
#define KBASE(t) ((j_lo + (t)) * KVBLK)
#define ACT(t) (KBASE(t) <= qlo + QBLK - 1 && KBASE(t) + KVBLK - 1 >= qlo - W + 1)
#define MASKT(P0_, P1_, t) do { const int kb_ = KBASE(t); if ((!SK || ACT(t)) && (kb_ + KVBLK - 1 > qlo || kb_ <= qlo + QBLK - 1 - W)) mask_tile(P0_, P1_, qm - kb_, (unsigned)W); } while (0)
    constexpr int NQL = F32 ? 16 : 8;
    constexpr bool SK = WSKIP && !F32;
#define SEAM_K0() do { VMWN(NQL); if constexpr (F32) { SWRITE_KF(0); SBAR(); SLOAD_F((const float*)nxt.V, kbn); } else { SWRITE_HK(0); } SBAR(); } while (0)
    f32x16 pA0, pA1, pB0, pB1; float mnA, mnB, alA, alB; bf16x8 pa0, pa1, pa2, pa3;
    if constexpr (F32) { VMW(); SWRITE_VF(0); SBAR(); } else { SWRITE_HV(0); SBAR(); }
    if (NT > 1) { if constexpr (F32) SLOAD_F((const float*)Kh, KBASE(1)); else SLOAD_H(Kh, Vh, KBASE(1)); }
    SBAR(); qkt<0, SK>(pA0, pA1, K_lds, r32, hi, S.qr, ACT(0), ckl + KBASE(0) + 4 * hi);
    if constexpr (F32) { if (NT > 1) { VMW(); SWRITE_KF(1); SBAR(); SLOAD_F((const float*)Vh, KBASE(1)); } }
    MASKT(pA0, pA1, 0); partialSM(pA0, pA1, m_reg, mnA, alA);
    if (NT > 1) { VMW(); if constexpr (F32) { SWRITE_VF(1); SBAR(); if (NT > 2) SLOAD_F((const float*)Kh, KBASE(2)); } else SWRITE_H(1); }
    __syncthreads();
#define HALF_STEP(PX0, PX1, mnX, alX, PY0, PY1, alY, t, KB, VB, SB) do {                                                      \
        SBAR(); qkt<KB, SK>(PX0, PX1, K_lds, r32, hi, S.qr, ACT(t), ckl + KBASE(t) + 4 * hi);                                             \
        finishSM(PY0, PY1, alY, l_reg, pa0, pa1, pa2, pa3); SBAR();                                                           \
        if ((t) + 1 < NT) { if constexpr (F32) { VMW(); SWRITE_KF(SB); SBAR(); SLOAD_F((const float*)Vh, KBASE((t) + 1)); }  \
                            else { SLOAD_H(Kh, Vh, KBASE((t) + 1)); } SBAR(); }                                               \
        pv_tile<VB, SK>(o, vb0, pa0, pa1, pa2, pa3, ACT((t) - 1)); MASKT(PX0, PX1, (t)); partialSM(PX0, PX1, m_reg, mnX, alX);                                        \
        __syncthreads();                                                                                                      \
        if ((t) + 1 < NT) { VMW(); if constexpr (F32) { SWRITE_VF(SB); SBAR(); if ((t) + 2 < NT) SLOAD_F((const float*)Kh, KBASE((t) + 2)); } \
                            else { SWRITE_H(SB); } }                                                                          \
        RESC(alX); __syncthreads(); } while (0)
    for (int t = 1; t + 1 < NT; t += 2) {
        HALF_STEP(pB0, pB1, mnB, alB, pA0, pA1, alA, t, 1, 0, 0);
        HALF_STEP(pA0, pA1, mnA, alA, pB0, pB1, alB, t + 1, 0, 1, 1);
    }
    const bool even = (NT & 1) == 0;
    if (even) { SBAR(); qkt<1, SK>(pB0, pB1, K_lds, r32, hi, S.qr, ACT(NT - 1), ckl + KBASE(NT - 1) + 4 * hi); SBAR(); }
#define QROW(e) (nxt.Q + (size_t)(wid * QBLK + r32) * D + ((e) >> 1) * 16 + hi * 8 + ((e) & 1) * 4)
    if constexpr (F32) { SLOAD_F((const float*)nxt.K, kbn); SBAR();
#pragma unroll
        for (int e = 0; e < 8; ++e) S.tq[e] = *(const f32x4*)QROW(e); }
    else { SLOAD_H(nxt.K, nxt.V, kbn); SBAR();
#pragma unroll
        for (int d0 = 0; d0 < 8; ++d0) S.qr[d0] = load8<TIn>(nxt.Q + (size_t)(wid * QBLK + r32) * D + d0 * 16 + hi * 8); }
    SBAR();
    finishSM(pA0, pA1, alA, l_reg, pa0, pa1, pa2, pa3); SBAR();
    if constexpr (F32) {
#pragma unroll
        for (int e = 8; e < 16; ++e) S.tq[e] = *(const f32x4*)QROW(e); SBAR(); }
#undef QROW
    pv_tile<0, SK>(o, vb0, pa0, pa1, pa2, pa3, ACT(even ? NT - 2 : NT - 1));
    if (even) { MASKT(pB0, pB1, NT - 1); partialSM(pB0, pB1, m_reg, mnB, alB); __syncthreads(); RESC(alB);
        finishSM(pB0, pB1, alB, l_reg, pa0, pa1, pa2, pa3); SBAR(); pv_tile<1, SK>(o, vb0, pa0, pa1, pa2, pa3, ACT(NT - 1)); }
    SBAR(); SEAM_K0();
    if (hi == 0) li_l[r32] = l_reg; asm volatile("s_waitcnt lgkmcnt(0)" ::: "memory");
    float rli[16];
#pragma unroll
    for (int r = 0; r < 16; ++r) rli[r] = __builtin_amdgcn_rcpf(li_l[crow(r, hi)]);
    TOut* Ow = cur.O + (size_t)(wid * QBLK) * OSTR;
#pragma unroll
    for (int r = 0; r < 16; ++r) { const int orow = crow(r, hi);
#pragma unroll
        for (int d0 = 0; d0 < 4; ++d0) { const float v = o[d0][r] * rli[r];
            if constexpr (same_t<TOut, float>::v) { Ow[(size_t)orow * OSTR + d0 * 32 + r32] = v; }
            else { const float vn = __shfl_xor(v, 1);
                   if ((r32 & 1) == 0) *(unsigned*)(Ow + (size_t)orow * OSTR + d0 * 32 + r32) = cvtpk(v, vn); } } }
    if constexpr (F32) {
#pragma unroll
        for (int d0 = 0; d0 < 8; ++d0) S.qr[d0] = pack8(S.tq[2 * d0], S.tq[2 * d0 + 1]); }
    __syncthreads();
#undef RESC
#undef KBASE
#undef ACT
#undef MASKT
#undef SEAM_K0
#undef HALF_STEP
}
#undef ROW
#undef VMW
#undef VMWN
#undef SLOAD_H
#undef SWRITE_HK
#undef SWRITE_HV
#undef SWRITE_H
#undef SLOAD_F
#undef SWRITE_KF
#undef SWRITE_VF

}
#define DI __device__ __forceinline__
typedef unsigned short bf16_t;
typedef short bf16x8 __attribute__((ext_vector_type(8)));
typedef float f32x4 __attribute__((ext_vector_type(4)));
typedef unsigned u32x4 __attribute__((ext_vector_type(4)));
typedef unsigned u32x2 __attribute__((ext_vector_type(2)));
using pg8::cvt_pk_bf16;
constexpr int MT = 32768, DM = 1024, SEQ = 4096, NBAT = 8, DFF = 2816, NTHR = 512;
constexpr float EPS = 1e-6f;
constexpr int LDS_TOTAL = 131072 + 64;

constexpr size_t SZ_WFIN = 5632ull * 1024 * 2, SZ_WFOUT = 1024ull * 2816 * 2;
constexpr size_t OFF_WFIN = 0;
constexpr size_t OFF_WFOUT = 2 * SZ_WFIN;
constexpr size_t OFF_WMIN = OFF_WFOUT + 2 * SZ_WFOUT;
constexpr size_t OFF_WMOUT = OFF_WMIN + 5888ull * 1024 * 2;
constexpr size_t OFF_WG = OFF_WMOUT + 1024ull * 2048 * 2;
constexpr size_t OFF_YCAT = OFF_WG + 8ull * 256 * 128 * 2;
constexpr size_t OFF_XBCP = OFF_YCAT + (size_t)MT * 2048 * 2;
constexpr size_t OFF_QKV = OFF_XBCP + (size_t)MT * 1536 * 2;
constexpr size_t OFF_ST = OFF_QKV + 3ull * MT * 1024 * 2;
constexpr size_t OFF_XN = OFF_ST + (size_t)MT * 1024 * 2;
constexpr size_t OFF_MISC = OFF_XN + (size_t)MT * 1536 * 2;
constexpr size_t OFF_CUM = OFF_MISC + (size_t)MT * 32 * 4;
constexpr size_t OFF_DT = OFF_CUM + 64ull * 4096 * 4;
constexpr size_t OFF_ACS = OFF_DT + (size_t)MT * 16 * 4;
constexpr size_t OFF_RH = OFF_ACS + (size_t)MT * 16 * 4;
constexpr size_t OFF_RA = OFF_RH + 8ull * 64 * 1024 * 4;
constexpr size_t OFF_RC = OFF_RA + 8ull * 64 * 1024 * 4;
constexpr size_t OFF_BAR = OFF_RC + 8ull * 64 * 1024 * 4;
constexpr size_t WS_END = OFF_BAR + 16384;

struct Params {
    const float* x; const float* norm_g; const float* ffn_w_in; const float* ffn_w_out; const float* hyb_w_in; const float* ssm_conv_w; const float* ssm_conv_b;
    const float* ssm_dt_bias; const float* ssm_a_log; const float* ssm_d; const float* ssm_norm_g; const float* fox_b_f; const float* hyb_w_out;
    const float* rec_w_in; const float* rec_conv_w; const float* rec_conv_b; const float* rec_w_a; const float* rec_b_a; const float* rec_w_x; const float* rec_b_x;
    const float* rec_lambda; const float* rec_w_out;
    float* out; unsigned char* ws; int ph_lo, ph_hi;
};

DI bf16_t f2bf(float f) { unsigned u = __float_as_uint(f); u += 0x7FFFu + ((u >> 16) & 1u); return (bf16_t)(u >> 16); }
DI float bf2f(bf16_t b) { return __uint_as_float(((unsigned)b) << 16); }
DI float bflo(unsigned w) { return __uint_as_float(w << 16); }
DI float bfhi(unsigned w) { return __uint_as_float(w & 0xFFFF0000u); }
DI float sigmoidf_(float x) { return 1.0f / (1.0f + __expf(-x)); }
DI float siluf_(float x) { return x * __builtin_amdgcn_rcpf(1.0f + __expf(-x)); }
DI float softplusf_(float x) { return x > 20.f ? x : log1pf(__expf(x)); }
DI float logsigf_(float x) { return fminf(x, 0.f) - log1pf(__expf(-fabsf(x))); }
DI float geluf_(float x) { const float t = 1.5957691216057308f * (x + 0.044715f * x * x * x); return x * __builtin_amdgcn_rcpf(1.0f + __expf(-t)); }
#define MFMA16(a, b, c) __builtin_amdgcn_mfma_f32_16x16x32_bf16((a), (b), (c), 0, 0, 0)

struct EpiPlain {
    static constexpr bool PERM = true, AFTER_DRAIN = false;
    bf16_t* O; int ldc;
    DI void operator()(const pg8::f32x4 (&acc)[2][2][4][2], const pg8::Unit& u, int wr, int wc, int fr, int fq) const {
        const int row0 = u.pm * 256 + wr * 64 + fr, col0 = u.pn * 256 + wc * 32 + 8 * fq;
#pragma unroll
        for (int ai = 0; ai < 2; ++ai)
#pragma unroll
            for (int m = 0; m < 4; ++m) { bf16_t* rowp = O + (size_t)(row0 + ai * 128 + m * 16) * ldc + col0;
#pragma unroll
                for (int bj = 0; bj < 2; ++bj) { const pg8::f32x4 v0 = acc[ai][bj][m][0], v1 = acc[ai][bj][m][1];
                    u32x4 w; w.x = cvt_pk_bf16(v0[0], v0[1]); w.y = cvt_pk_bf16(v0[2], v0[3]); w.z = cvt_pk_bf16(v1[0], v1[1]); w.w = cvt_pk_bf16(v1[2], v1[3]);
                    *(u32x4*)(rowp + bj * 128) = w; } }
    }
};
struct EpiSwiglu {
    static constexpr bool PERM = true, AFTER_DRAIN = false;
    bf16_t* O;
    DI void operator()(const pg8::f32x4 (&acc)[2][2][4][2], const pg8::Unit& u, int wr, int wc, int fr, int fq) const {
        const int row0 = u.pm * 256 + wr * 64 + fr, col0 = u.pn * 128 + wc * 32 + 8 * fq;
#pragma unroll
        for (int ai = 0; ai < 2; ++ai)
#pragma unroll
            for (int m = 0; m < 4; ++m) { bf16_t* rowp = O + (size_t)(row0 + ai * 128 + m * 16) * DFF + col0;
                float h[8];
#pragma unroll
                for (int n = 0; n < 2; ++n)
#pragma unroll
                    for (int j = 0; j < 4; ++j) h[n * 4 + j] = siluf_(acc[ai][0][m][n][j]) * acc[ai][1][m][n][j];
                u32x4 w; w.x = cvt_pk_bf16(h[0], h[1]); w.y = cvt_pk_bf16(h[2], h[3]); w.z = cvt_pk_bf16(h[4], h[5]); w.w = cvt_pk_bf16(h[6], h[7]);
                *(u32x4*)rowp = w; }
    }
};
struct EpiHyb {
    static constexpr bool PERM = true, AFTER_DRAIN = false;
    bf16_t* ycat; bf16_t* xbcp; bf16_t* qkv; float* misc;
    DI void operator()(const pg8::f32x4 (&acc)[2][2][4][2], const pg8::Unit& u, int wr, int wc, int fr, int fq) const {
        const int row0 = u.pm * 256 + wr * 64 + fr, pn = u.pn;
        if (pn == 22) {
            if (wc == 0) {
#pragma unroll
                for (int ai = 0; ai < 2; ++ai)
#pragma unroll
                    for (int m = 0; m < 4; ++m) { float* rowp = misc + (size_t)(row0 + ai * 128 + m * 16) * 32 + 8 * fq;
                        *(pg8::f32x4*)rowp = acc[ai][0][m][0]; *(pg8::f32x4*)(rowp + 4) = acc[ai][0][m][1]; }
            }
            return;
        }
#pragma unroll
        for (int ai = 0; ai < 2; ++ai)
#pragma unroll
            for (int m = 0; m < 4; ++m) { const int r = row0 + ai * 128 + m * 16;
#pragma unroll
                for (int bj = 0; bj < 2; ++bj) { const pg8::f32x4 v0 = acc[ai][bj][m][0], v1 = acc[ai][bj][m][1];
                    u32x4 w; w.x = cvt_pk_bf16(v0[0], v0[1]); w.y = cvt_pk_bf16(v0[2], v0[3]); w.z = cvt_pk_bf16(v1[0], v1[1]); w.w = cvt_pk_bf16(v1[2], v1[3]);
                    const int cl = bj * 128 + wc * 32 + 8 * fq;
                    bf16_t* dst;
                    if (pn < 4) dst = ycat + (size_t)r * 2048 + pn * 256 + cl;
                    else if (pn < 10) dst = xbcp + (size_t)r * 1536 + (pn - 4) * 256 + cl;
                    else { const int t = (pn - 10) >> 2, head = ((pn - 10) & 3) * 2 + bj, b = r >> 12, s = r & 4095;
                        dst = qkv + (size_t)t * ((size_t)MT * 1024) + ((size_t)(b * 8 + head) * SEQ + s) * 128 + wc * 32 + 8 * fq; }
                    *(u32x4*)dst = w; } }
    }
};
struct EpiRec {
    static constexpr bool PERM = true, AFTER_DRAIN = false;
    bf16_t* G; bf16_t* X;
    DI void operator()(const pg8::f32x4 (&acc)[2][2][4][2], const pg8::Unit& u, int wr, int wc, int fr, int fq) const {
        const int row0 = u.pm * 256 + wr * 64 + fr; const bool isg = u.pn < 4;
        bf16_t* base = (isg ? G : X) + (u.pn & 3) * 256 + wc * 32 + 8 * fq;
#pragma unroll
        for (int ai = 0; ai < 2; ++ai)
#pragma unroll
            for (int m = 0; m < 4; ++m) { bf16_t* rowp = base + (size_t)(row0 + ai * 128 + m * 16) * 1024;
#pragma unroll
                for (int bj = 0; bj < 2; ++bj) { pg8::f32x4 v0 = acc[ai][bj][m][0], v1 = acc[ai][bj][m][1];
                    if (isg) {
#pragma unroll
                        for (int j = 0; j < 4; ++j) { v0[j] = geluf_(v0[j]); v1[j] = geluf_(v1[j]); } }
                    u32x4 w; w.x = cvt_pk_bf16(v0[0], v0[1]); w.y = cvt_pk_bf16(v0[2], v0[3]); w.z = cvt_pk_bf16(v1[0], v1[1]); w.w = cvt_pk_bf16(v1[2], v1[3]);
                    *(u32x4*)(rowp + bj * 128) = w; } }
    }
};
template <class Epi> DI void run_gemm(unsigned char* shm, const bf16_t* A, const bf16_t* Bt, int N, int K, const Epi& E) {
    pg8::Gemm g; g.A = A; g.Bt = Bt; g.M = MT; g.N = N; g.K = K;
    pg8::StaticOrder S; S.init(MT, N, (int)gridDim.x, (int)bidx());
    pg8::gemm_phase<Epi, pg8::StaticOrder, false>((PG8_LAS unsigned char*)shm, g, S, E, nullptr);
    __syncthreads();
}

DI int srccol(int map, int j) {
    if (map == 0) return j;
    if (map == 1) { const int pn = j >> 8, c = j & 255; return c < 128 ? pn * 128 + c : DFF + pn * 128 + (c - 128); }
    if (j < 2560) return j;
    if (j < 5632) return j + 16;
    if (j < 5648) return 2560 + (j - 5632);
    if (j < 5656) return j;
    return -1;
}
DI void transpose_job(unsigned char* shm, const float* src, int ld, int K, int N, bf16_t* dst, int map, int rot) {
    float* tile = (float*)shm;
    const int tk = K >> 6, ntiles = (N >> 7) * tk, tid = tidx(), G = gridDim.x;
    const int start = (int)((bidx() + G - (rot % G)) % G);
    for (int t = start; t < ntiles; t += 2 * G) {
        const bool two = t + G < ntiles;
        f32x4 v[2][4];
#pragma unroll
        for (int u = 0; u < 2; ++u) { const int tt = t + u * G; if (u == 1 && !two) break;
            const int j0 = (tt / tk) << 7, k0 = (tt % tk) << 6;
#pragma unroll
            for (int i = 0; i < 4; ++i) { const int q = tid + i * NTHR, kk = q >> 5, j4 = (q & 31) * 4, sc = srccol(map, j0 + j4);
                v[u][i] = sc >= 0 ? __builtin_nontemporal_load((const f32x4*)(src + (size_t)(k0 + kk) * ld + sc)) : (f32x4){0.f, 0.f, 0.f, 0.f}; } }
#pragma unroll
        for (int u = 0; u < 2; ++u) { if (u == 1 && !two) break;
#pragma unroll
            for (int i = 0; i < 4; ++i) { const int q = tid + i * NTHR, kk = q >> 5, j4 = (q & 31) * 4;
#pragma unroll
                for (int cc = 0; cc < 4; ++cc) tile[u * (64 * 129) + kk * 129 + j4 + cc] = v[u][i][cc]; } }
        __syncthreads();
#pragma unroll
        for (int u = 0; u < 2; ++u) { const int tt = t + u * G; if (u == 1 && !two) break;
            const int j0 = (tt / tk) << 7, k0 = (tt % tk) << 6;
#pragma unroll
            for (int i = 0; i < 2; ++i) { const int q = tid + i * NTHR, kg = q & 7, jj = q >> 3;
                const float* tp = tile + u * (64 * 129) + (kg * 8) * 129 + jj;
                u32x4 o; o.x = cvt_pk_bf16(tp[0], tp[129]); o.y = cvt_pk_bf16(tp[2 * 129], tp[3 * 129]); o.z = cvt_pk_bf16(tp[4 * 129], tp[5 * 129]); o.w = cvt_pk_bf16(tp[6 * 129], tp[7 * 129]);
                *(u32x4*)(dst + (size_t)(j0 + jj) * K + k0 + kg * 8) = o; } }
        __syncthreads();
    }
}
DI void convert_weights(unsigned char* shm, const Params& p, int layer) {
    unsigned char* ws = p.ws; int rot = 0;
    for (int s = 0; s < 2; ++s) {
        transpose_job(shm, p.ffn_w_in + (size_t)(layer * 2 + s) * 1024 * 5632, 5632, 1024, 5632, (bf16_t*)(ws + OFF_WFIN + s * SZ_WFIN), 1, rot); rot += 44 * 16;
        transpose_job(shm, p.ffn_w_out + (size_t)(layer * 2 + s) * 2816 * 1024, 1024, 2816, 1024, (bf16_t*)(ws + OFF_WFOUT + s * SZ_WFOUT), 0, rot); rot += 8 * 44;
    }
    const int i = layer >> 1;
    if ((layer & 1) == 0) {
        transpose_job(shm, p.hyb_w_in + (size_t)i * 1024 * 5656, 5656, 1024, 5888, (bf16_t*)(ws + OFF_WMIN), 2, rot); rot += 46 * 16;
        transpose_job(shm, p.hyb_w_out + (size_t)i * 2048 * 1024, 1024, 2048, 1024, (bf16_t*)(ws + OFF_WMOUT), 0, rot);
    } else {
        transpose_job(shm, p.rec_w_in + (size_t)i * 1024 * 2048, 2048, 1024, 2048, (bf16_t*)(ws + OFF_WMIN), 0, rot); rot += 16 * 16;
        transpose_job(shm, p.rec_w_out + (size_t)i * 1024 * 1024, 1024, 1024, 1024, (bf16_t*)(ws + OFF_WMOUT), 0, rot); rot += 8 * 16;
        for (int nb = 0; nb < 8; ++nb) {
            transpose_job(shm, p.rec_w_a + ((size_t)i * 8 + nb) * 128 * 128, 128, 128, 128, (bf16_t*)(ws + OFF_WG) + (size_t)nb * 256 * 128, 0, rot); rot += 2;
            transpose_job(shm, p.rec_w_x + ((size_t)i * 8 + nb) * 128 * 128, 128, 128, 128, (bf16_t*)(ws + OFF_WG) + (size_t)nb * 256 * 128 + 128 * 128, 0, rot); rot += 2;
        }
    }
}

DI void resnorm_phase(const float* xin, const bf16_t* h, float w, const float* gpost, const float* gpre, float* xout, bf16_t* xn) {
    const int lane = tidx() & 63, gw = bidx() * 8 + (tidx() >> 6), nw = gridDim.x * 8;
    for (int r0 = gw; r0 < MT; r0 += 2 * nw) {
        f32x4 xv[2][4]; u32x2 hq[2][4];
#pragma unroll
        for (int u = 0; u < 2; ++u)
#pragma unroll
            for (int i = 0; i < 4; ++i) { const size_t o = (size_t)(r0 + u * nw) * DM + i * 256 + lane * 4;
                if (r0 + u * nw < MT) { xv[u][i] = __builtin_nontemporal_load((const f32x4*)(xin + o)); if (h) hq[u][i] = __builtin_nontemporal_load((const u32x2*)(h + o)); }
                else { xv[u][i] = (f32x4){0.f, 0.f, 0.f, 0.f}; hq[u][i] = (u32x2){0u, 0u}; } }
#pragma unroll
        for (int u = 0; u < 2; ++u) {
            const int r = r0 + u * nw; if (r >= MT) break;
            if (h) {
                float hv[4][4]; float ss = 0.f;
#pragma unroll
                for (int i = 0; i < 4; ++i) { const u32x2 q = hq[u][i];
                    hv[i][0] = bflo(q.x); hv[i][1] = bfhi(q.x); hv[i][2] = bflo(q.y); hv[i][3] = bfhi(q.y);
                    ss += hv[i][0] * hv[i][0] + hv[i][1] * hv[i][1] + hv[i][2] * hv[i][2] + hv[i][3] * hv[i][3]; }
#pragma unroll
                for (int o = 32; o > 0; o >>= 1) ss += __shfl_xor(ss, o);
                const float sc = w * rsqrtf(ss * (1.0f / DM) + EPS);
#pragma unroll
                for (int i = 0; i < 4; ++i) { const f32x4 g = *(const f32x4*)(gpost + i * 256 + lane * 4);
#pragma unroll
                    for (int j = 0; j < 4; ++j) xv[u][i][j] += sc * hv[i][j] * g[j]; }
            }
#pragma unroll
            for (int i = 0; i < 4; ++i) __builtin_nontemporal_store(xv[u][i], (f32x4*)(xout + (size_t)r * DM + i * 256 + lane * 4));
            if (gpre) {
                float ss = 0.f;
#pragma unroll
                for (int i = 0; i < 4; ++i) ss += xv[u][i][0] * xv[u][i][0] + xv[u][i][1] * xv[u][i][1] + xv[u][i][2] * xv[u][i][2] + xv[u][i][3] * xv[u][i][3];
#pragma unroll
                for (int o = 32; o > 0; o >>= 1) ss += __shfl_xor(ss, o);
                const float sc = rsqrtf(ss * (1.0f / DM) + EPS);
#pragma unroll
                for (int i = 0; i < 4; ++i) { const f32x4 g = *(const f32x4*)(gpre + i * 256 + lane * 4);
                    u32x2 q; q.x = cvt_pk_bf16(xv[u][i][0] * sc * g[0], xv[u][i][1] * sc * g[1]); q.y = cvt_pk_bf16(xv[u][i][2] * sc * g[2], xv[u][i][3] * sc * g[3]);
                    *(u32x2*)(xn + (size_t)r * DM + i * 256 + lane * 4) = q; }
            }
        }
    }
}
DI void hyb_prep_phase(unsigned char* shm, const Params& p, int li) {
    unsigned char* ws = p.ws; const int tid = tidx(), lane = tid & 63, wid = tid >> 6;
    const float* misc = (const float*)(ws + OFF_MISC);
    { float* cum = (float*)(ws + OFF_CUM); float* sw = (float*)shm;
      for (int it = bidx(); it < 64; it += gridDim.x) {
        const int b = it >> 3, h = it & 7; const float bf = p.fox_b_f[li * 8 + h];
        float v[8]; float run = 0.f;
#pragma unroll
        for (int j = 0; j < 8; ++j) { const float fr_ = misc[(size_t)(b * SEQ + tid * 8 + j) * 32 + 16 + h]; run += logsigf_(fr_ + bf); v[j] = run; }
        float inc = run;
#pragma unroll
        for (int o = 1; o < 64; o <<= 1) { const float t = __shfl_up(inc, o); if (lane >= o) inc += t; }
        if (lane == 63) sw[wid] = inc;
        __syncthreads();
        float base = inc - run;
        for (int w2 = 0; w2 < wid; ++w2) base += sw[w2];
#pragma unroll
        for (int j = 0; j < 8; ++j) cum[(size_t)it * SEQ + tid * 8 + j] = base + v[j];
        __syncthreads();
      } }
    { float* dtb = (float*)(ws + OFF_DT); float* acs = (float*)(ws + OFF_ACS); float* sA = (float*)shm;
      for (int it = bidx(); it < 256; it += gridDim.x) {
        const int tok0 = it * 128, l = tid >> 2, hq = (tid & 3) * 4;
        const f32x4 raw = *(const f32x4*)(misc + (size_t)(tok0 + l) * 32 + hq);
        f32x4 dtv;
#pragma unroll
        for (int j = 0; j < 4; ++j) { dtv[j] = softplusf_(raw[j] + p.ssm_dt_bias[li * 16 + hq + j]); sA[l * 16 + hq + j] = dtv[j] * (-__expf(p.ssm_a_log[li * 16 + hq + j])); }
        *(f32x4*)(dtb + (size_t)(tok0 + l) * 16 + hq) = dtv;
        __syncthreads();
        if (tid < 16) { float run = 0.f; for (int q = 0; q < 128; ++q) { run += sA[q * 16 + tid]; sA[q * 16 + tid] = run; } }
        __syncthreads();
        *(f32x4*)(acs + (size_t)(tok0 + l) * 16 + hq) = *(const f32x4*)(sA + l * 16 + hq);
        __syncthreads();
      } }
    { const bf16_t* src = (const bf16_t*)(ws + OFF_XBCP); bf16_t* dst = (bf16_t*)(ws + OFF_XN);
      const float* cw = p.ssm_conv_w + (size_t)li * 4 * 1536; const float* cb = p.ssm_conv_b + (size_t)li * 1536;
      const int total = (MT / 16) * 192;
      for (int idx = bidx() * NTHR + tid; idx < total; idx += gridDim.x * NTHR) {
        const int tb = idx / 192, c0 = (idx % 192) * 8, t0 = tb * 16, s0 = t0 & (SEQ - 1);
        float w[4][8], bias[8];
#pragma unroll
        for (int k = 0; k < 4; ++k) { const f32x4 a = *(const f32x4*)(cw + k * 1536 + c0), b2 = *(const f32x4*)(cw + k * 1536 + c0 + 4);
#pragma unroll
            for (int j = 0; j < 4; ++j) { w[k][j] = a[j]; w[k][4 + j] = b2[j]; } }
        { const f32x4 a = *(const f32x4*)(cb + c0), b2 = *(const f32x4*)(cb + c0 + 4);
#pragma unroll
          for (int j = 0; j < 4; ++j) { bias[j] = a[j]; bias[4 + j] = b2[j]; } }
        float h0[8], h1[8], h2[8];
#pragma unroll
        for (int j = 0; j < 8; ++j) { h0[j] = 0.f; h1[j] = 0.f; h2[j] = 0.f; }
        if (s0 > 0) {
            const u32x4 a = *(const u32x4*)(src + (size_t)(t0 - 3) * 1536 + c0), b2 = *(const u32x4*)(src + (size_t)(t0 - 2) * 1536 + c0), c2 = *(const u32x4*)(src + (size_t)(t0 - 1) * 1536 + c0);
#pragma unroll
            for (int j = 0; j < 4; ++j) { h0[2 * j] = bflo(a[j]); h0[2 * j + 1] = bfhi(a[j]); h1[2 * j] = bflo(b2[j]); h1[2 * j + 1] = bfhi(b2[j]); h2[2 * j] = bflo(c2[j]); h2[2 * j + 1] = bfhi(c2[j]); }
        }
        u32x4 rw[16];
#pragma unroll
        for (int q = 0; q < 16; ++q) rw[q] = __builtin_nontemporal_load((const u32x4*)(src + (size_t)(t0 + q) * 1536 + c0));
#pragma unroll
        for (int q = 0; q < 16; ++q) {
            const u32x4 a = rw[q];
            float cur[8], y[8];
#pragma unroll
            for (int j = 0; j < 4; ++j) { cur[2 * j] = bflo(a[j]); cur[2 * j + 1] = bfhi(a[j]); }
#pragma unroll
            for (int j = 0; j < 8; ++j) { y[j] = siluf_(bias[j] + w[0][j] * h0[j] + w[1][j] * h1[j] + w[2][j] * h2[j] + w[3][j] * cur[j]); h0[j] = h1[j]; h1[j] = h2[j]; h2[j] = cur[j]; }
            u32x4 o; o.x = cvt_pk_bf16(y[0], y[1]); o.y = cvt_pk_bf16(y[2], y[3]); o.z = cvt_pk_bf16(y[4], y[5]); o.w = cvt_pk_bf16(y[6], y[7]);
            *(u32x4*)(dst + (size_t)(t0 + q) * 1536 + c0) = o;
        }
      } }
}

constexpr int LDT = 136;
constexpr int RSX = 144;
typedef short s16x4 __attribute__((ext_vector_type(4)));
DI unsigned tr_lane_off(int lane, int rs) { return (unsigned)((8 * (lane >> 4) + ((lane >> 2) & 3)) * rs + (lane & 3) * 8); }
DI bf16x8 tr_frag(unsigned a, unsigned rs4) {
    s16x4 lo, hi;
    asm volatile("ds_read_b64_tr_b16 %0, %2\n\tds_read_b64_tr_b16 %1, %3\n\ts_waitcnt lgkmcnt(0)" : "=&v"(lo), "=&v"(hi) : "v"(a), "v"(a + rs4) : "memory");
    return (bf16x8){lo[0], lo[1], lo[2], lo[3], hi[0], hi[1], hi[2], hi[3]};
}
DI void tr_frag4(unsigned a, unsigned rs4, bf16x8 (&f)[4]) {
    s16x4 l0, h0, l1, h1, l2, h2, l3, h3; const unsigned b = a + rs4;
    asm volatile("ds_read_b64_tr_b16 %0, %8\n\tds_read_b64_tr_b16 %1, %9\n\tds_read_b64_tr_b16 %2, %8 offset:32\n\tds_read_b64_tr_b16 %3, %9 offset:32\n\t"
                 "ds_read_b64_tr_b16 %4, %8 offset:64\n\tds_read_b64_tr_b16 %5, %9 offset:64\n\tds_read_b64_tr_b16 %6, %8 offset:96\n\tds_read_b64_tr_b16 %7, %9 offset:96\n\ts_waitcnt lgkmcnt(0)"
                 : "=&v"(l0), "=&v"(h0), "=&v"(l1), "=&v"(h1), "=&v"(l2), "=&v"(h2), "=&v"(l3), "=&v"(h3) : "v"(a), "v"(b) : "memory");
    f[0] = (bf16x8){l0[0], l0[1], l0[2], l0[3], h0[0], h0[1], h0[2], h0[3]}; f[1] = (bf16x8){l1[0], l1[1], l1[2], l1[3], h1[0], h1[1], h1[2], h1[3]};
    f[2] = (bf16x8){l2[0], l2[1], l2[2], l2[3], h2[0], h2[1], h2[2], h2[3]}; f[3] = (bf16x8){l3[0], l3[1], l3[2], l3[3], h3[0], h3[1], h3[2], h3[3]};
}
DI void ssd_states_phase(unsigned char* shm, const Params& p) {
    unsigned char* ws = p.ws; const int tid = tidx(), lane = tid & 63, w = __builtin_amdgcn_readfirstlane(tid >> 6), fr = lane & 15, fq = lane >> 4;
    const bf16_t* xbc = (const bf16_t*)(ws + OFF_XN); const float* dtb = (const float*)(ws + OFF_DT); const float* acs = (const float*)(ws + OFF_ACS);
    bf16_t* st = (bf16_t*)(ws + OFF_ST);
    bf16_t* Bs = (bf16_t*)shm;
    unsigned char* Xs = shm + 128 * LDT * 2;
    const unsigned bsa = (unsigned)(uintptr_t)Bs + tr_lane_off(lane, LDT * 2) + (16 * w) * 2;
    const unsigned xsa = (unsigned)(uintptr_t)Xs + tr_lane_off(lane, RSX);
    for (int it = bidx(); it < 512; it += gridDim.x) {
        const int g = it & 1, bc = it >> 1, tok0 = bc * 128;
        __syncthreads();
#pragma unroll
        for (int i = 0; i < 4; ++i) { const int v = tid + i * NTHR, l = v >> 4, n8 = (v & 15) * 8;
            *(u32x4*)(Bs + l * LDT + n8) = *(const u32x4*)(xbc + (size_t)(tok0 + l) * 1536 + 1024 + g * 128 + n8); }
        for (int k = 0; k < 8; ++k) {
            const int hh = g * 8 + k; const float aend = acs[(size_t)(tok0 + 127) * 16 + hh];
            __syncthreads();
#pragma unroll
            for (int i = 0; i < 2; ++i) { const int v = tid + i * NTHR, l = v >> 3, p8 = (v & 7) * 8;
                const float wl = __expf(aend - acs[(size_t)(tok0 + l) * 16 + hh]) * dtb[(size_t)(tok0 + l) * 16 + hh];
                const u32x4 q = *(const u32x4*)(xbc + (size_t)(tok0 + l) * 1536 + hh * 64 + p8); u32x4 o;
#pragma unroll
                for (int j = 0; j < 4; ++j) o[j] = cvt_pk_bf16(bflo(q[j]) * wl, bfhi(q[j]) * wl);
                *(u32x4*)(Xs + l * RSX + p8 * 2) = o; }
            __syncthreads();
            f32x4 acc[4];
#pragma unroll
            for (int j = 0; j < 4; ++j) acc[j] = (f32x4){0.f, 0.f, 0.f, 0.f};
#pragma unroll
            for (int ks = 0; ks < 4; ++ks) { const bf16x8 a = tr_frag(bsa + 32 * ks * (LDT * 2), 4 * LDT * 2);
                bf16x8 b[4]; tr_frag4(xsa + 32 * ks * RSX, 4 * RSX, b);
#pragma unroll
                for (int j = 0; j < 4; ++j) acc[j] = MFMA16(a, b[j], acc[j]); }
            bf16_t* sp = st + ((size_t)bc * 16 + hh) * 8192;
#pragma unroll
            for (int j = 0; j < 4; ++j) { u32x2 o; o.x = cvt_pk_bf16(acc[j][0], acc[j][1]); o.y = cvt_pk_bf16(acc[j][2], acc[j][3]);
                *(u32x2*)(sp + (16 * j + fr) * 128 + 16 * w + 4 * fq) = o; }
        }
    }
    __syncthreads();
}
DI void ssd_carry_phase(const Params& p) {
    unsigned char* ws = p.ws; const float* acs = (const float*)(ws + OFF_ACS); bf16_t* st = (bf16_t*)(ws + OFF_ST);
    for (int idx = bidx() * NTHR + tidx(); idx < 128 * 1024; idx += gridDim.x * NTHR) {
        const int bh = idx >> 10, e8 = (idx & 1023) * 8, b = bh >> 4, h = bh & 15;
        float carry[8];
#pragma unroll
        for (int j = 0; j < 8; ++j) carry[j] = 0.f;
        for (int z0 = 0; z0 < 32; z0 += 8) {
            u32x4 q[8]; float dec[8];
#pragma unroll
            for (int zz = 0; zz < 8; ++zz) { const int z = z0 + zz; q[zz] = *(const u32x4*)(st + ((size_t)(b * 32 + z) * 16 + h) * 8192 + e8);
                dec[zz] = __expf(acs[(size_t)(b * SEQ + z * 128 + 127) * 16 + h]); }
#pragma unroll
            for (int zz = 0; zz < 8; ++zz) { const int z = z0 + zz;
                u32x4 o; o.x = cvt_pk_bf16(carry[0], carry[1]); o.y = cvt_pk_bf16(carry[2], carry[3]); o.z = cvt_pk_bf16(carry[4], carry[5]); o.w = cvt_pk_bf16(carry[6], carry[7]);
                *(u32x4*)(st + ((size_t)(b * 32 + z) * 16 + h) * 8192 + e8) = o;
#pragma unroll
                for (int j = 0; j < 4; ++j) { carry[2 * j] = carry[2 * j] * dec[zz] + bflo(q[zz][j]); carry[2 * j + 1] = carry[2 * j + 1] * dec[zz] + bfhi(q[zz][j]); } }
        }
    }
}

DI void ssd_out_phase(unsigned char* shm, const Params& p, int li) {
    unsigned char* ws = p.ws; const int tid = tidx(), lane = tid & 63, w = __builtin_amdgcn_readfirstlane(tid >> 6), fr = lane & 15, fq = lane >> 4;
    const bf16_t* xbc = (const bf16_t*)(ws + OFF_XN); const float* dtb = (const float*)(ws + OFF_DT); const float* acs = (const float*)(ws + OFF_ACS);
    const bf16_t* st = (const bf16_t*)(ws + OFF_ST); bf16_t* ycat = (bf16_t*)(ws + OFF_YCAT);
    constexpr int HB = 128 * RSX + 64 * LDT * 2;
    bf16_t* Cs = (bf16_t*)shm; bf16_t* Bs = Cs + 128 * LDT;
    bf16_t* Ml = (bf16_t*)(shm + 2 * HB);
    float* hv = (float*)(shm + 2 * HB + 128 * LDT * 2);
    float* ssq = hv + 512;
    const int tl = 16 * w + fr;
    const int sl0 = tid >> 3, sp8 = (tid & 7) * 8;
    const int tp0 = tid >> 4, tn8 = (tid & 15) * 8;
    for (int it = bidx(); it < 512; it += gridDim.x) {
        const int g = it & 1, bc = it >> 1, tok0 = bc * 128;
        __syncthreads();
#pragma unroll
        for (int i = 0; i < 4; ++i) { const int v = tid + i * NTHR, l = v >> 4, n8 = (v & 15) * 8;
            *(u32x4*)(Bs + l * LDT + n8) = *(const u32x4*)(xbc + (size_t)(tok0 + l) * 1536 + 1024 + g * 128 + n8);
            *(u32x4*)(Cs + l * LDT + n8) = *(const u32x4*)(xbc + (size_t)(tok0 + l) * 1536 + 1280 + g * 128 + n8); }
        if (tid < 128) ssq[tid] = 0.f;
        u32x4 xq[2], sq[2]; float dq[2], hq = 0.f;
#define SSD_FETCH(hh_) do { const int hh__ = (hh_);                                                                                          \
            _Pragma("unroll") for (int i = 0; i < 2; ++i) { xq[i] = *(const u32x4*)(xbc + (size_t)(tok0 + sl0 + 64 * i) * 1536 + hh__ * 64 + sp8);   \
                dq[i] = dtb[(size_t)(tok0 + sl0 + 64 * i) * 16 + hh__];                                                                        \
                sq[i] = *(const u32x4*)(st + ((size_t)bc * 16 + hh__) * 8192 + (tp0 + 32 * i) * 128 + tn8); }                                  \
            if (tid < 256) hq = (tid < 128 ? acs : dtb)[(size_t)(tok0 + (tid & 127)) * 16 + hh__]; } while (0)
#define SSD_STORE(buf_) do { unsigned char* hb_ = shm + (buf_) * HB;                                                                          \
            _Pragma("unroll") for (int i = 0; i < 2; ++i) { u32x4 o_;                                                                        \
                _Pragma("unroll") for (int j = 0; j < 4; ++j) o_[j] = cvt_pk_bf16(bflo(xq[i][j]) * dq[i], bfhi(xq[i][j]) * dq[i]);            \
                *(u32x4*)(hb_ + (sl0 + 64 * i) * RSX + sp8 * 2) = o_;                                                                         \
                *(u32x4*)((bf16_t*)(hb_ + 128 * RSX) + (tp0 + 32 * i) * LDT + tn8) = sq[i]; }                                                 \
            if (tid < 256) hv[(buf_) * 256 + tid] = hq; } while (0)
        SSD_FETCH(g * 8);
        __syncthreads();
        bf16x8 Cf[4];
#pragma unroll
        for (int ks = 0; ks < 4; ++ks) Cf[ks] = *(const bf16x8*)(Cs + tl * LDT + 32 * ks + 8 * fq);
        f32x4 G[8];
#pragma unroll
        for (int j = 0; j < 8; ++j) { G[j] = (f32x4){0.f, 0.f, 0.f, 0.f};
            if (j <= w) {
#pragma unroll
                for (int ks = 0; ks < 4; ++ks) { const bf16x8 a = *(const bf16x8*)(Bs + (16 * j + fr) * LDT + 32 * ks + 8 * fq); G[j] = MFMA16(a, Cf[ks], G[j]); } } }
        __syncthreads();
        SSD_STORE(0);
        __syncthreads();
        for (int k = 0; k < 8; ++k) {
            const int hh = g * 8 + k, cur = k & 1; const float Dh = p.ssm_d[li * 16 + hh];
            if (k < 7) SSD_FETCH(hh + 1);
            u32x2 zq[4];
#pragma unroll
            for (int j = 0; j < 4; ++j) zq[j] = *(const u32x2*)(ycat + (size_t)(tok0 + tl) * 2048 + hh * 64 + 16 * j + 4 * fq);
            const unsigned char* hb = shm + cur * HB; const bf16_t* St = (const bf16_t*)(hb + 128 * RSX);
            const float* acs_s = hv + cur * 256; const float* dt_s = acs_s + 128;
            const unsigned xsa = (unsigned)(uintptr_t)hb + tr_lane_off(lane, RSX);
            const float al = acs_s[tl], dsk = Dh * __builtin_amdgcn_rcpf(dt_s[tl]);
#pragma unroll
            for (int j = 0; j < 8; ++j) {
                if (j <= (w | 1)) { const int s0 = 16 * j + 4 * fq; float m[4] = {0.f, 0.f, 0.f, 0.f};
                    if (j <= w) { const f32x4 as_ = *(const f32x4*)(acs_s + s0);
#pragma unroll
                        for (int i = 0; i < 4; ++i) m[i] = G[j][i] * __expf(fminf(al - as_[i], 0.f));
                        if (j == w) {
#pragma unroll
                            for (int i = 0; i < 4; ++i) { const int dd = fr - 4 * fq - i; m[i] = dd >= 0 ? m[i] : 0.f; if (dd == 0) m[i] += dsk; } } }
                    u32x2 o; o.x = cvt_pk_bf16(m[0], m[1]); o.y = cvt_pk_bf16(m[2], m[3]); *(u32x2*)(Ml + tl * LDT + s0) = o; } }
            f32x4 yd[4], yo[4];
#pragma unroll
            for (int j = 0; j < 4; ++j) { yd[j] = (f32x4){0.f, 0.f, 0.f, 0.f}; yo[j] = (f32x4){0.f, 0.f, 0.f, 0.f}; }
#pragma unroll
            for (int ks = 0; ks < 4; ++ks) {
                if (ks <= (w >> 1)) { const bf16x8 b = *(const bf16x8*)(Ml + tl * LDT + 32 * ks + 8 * fq);
#pragma unroll
                    for (int j = 0; j < 4; ++j) { const bf16x8 a = tr_frag(xsa + 32 * ks * RSX + 16 * j * 2, 4 * RSX); yd[j] = MFMA16(a, b, yd[j]); } } }
#pragma unroll
            for (int ks = 0; ks < 4; ++ks)
#pragma unroll
                for (int j = 0; j < 4; ++j) { const bf16x8 a = *(const bf16x8*)(St + (16 * j + fr) * LDT + 32 * ks + 8 * fq); yo[j] = MFMA16(a, Cf[ks], yo[j]); }
            const float ea = __expf(al); float part = 0.f;
#pragma unroll
            for (int j = 0; j < 4; ++j) { const float zv[4] = {bflo(zq[j].x), bfhi(zq[j].x), bflo(zq[j].y), bfhi(zq[j].y)}; float y[4];
#pragma unroll
                for (int i = 0; i < 4; ++i) { y[i] = (yd[j][i] + ea * yo[j][i]) * siluf_(zv[i]); part += y[i] * y[i]; }
                u32x2 o; o.x = cvt_pk_bf16(y[0], y[1]); o.y = cvt_pk_bf16(y[2], y[3]); *(u32x2*)(ycat + (size_t)(tok0 + tl) * 2048 + hh * 64 + 16 * j + 4 * fq) = o; }
            part += __shfl_xor(part, 16); part += __shfl_xor(part, 32);
            if (fq == 0) ssq[tl] += part;
            if (k < 7) SSD_STORE(cur ^ 1);
            __syncthreads();
        }
#undef SSD_FETCH
#undef SSD_STORE
        asm volatile("s_waitcnt vmcnt(0)" ::: "memory"); __syncthreads();
        { const f32x4 g0 = *(const f32x4*)(p.ssm_norm_g + li * 1024 + g * 512 + lane * 8), g1 = *(const f32x4*)(p.ssm_norm_g + li * 1024 + g * 512 + lane * 8 + 4);
          for (int rr = 0; rr < 16; ++rr) { const int l = 16 * w + rr; const float sc = rsqrtf(ssq[l] * (1.0f / 512.0f) + EPS);
            bf16_t* yp = ycat + (size_t)(tok0 + l) * 2048 + g * 512 + lane * 8;
            const u32x4 q = *(const u32x4*)yp; u32x4 o;
            o.x = cvt_pk_bf16(bflo(q.x) * sc * g0[0], bfhi(q.x) * sc * g0[1]); o.y = cvt_pk_bf16(bflo(q.y) * sc * g0[2], bfhi(q.y) * sc * g0[3]);
            o.z = cvt_pk_bf16(bflo(q.z) * sc * g1[0], bfhi(q.z) * sc * g1[1]); o.w = cvt_pk_bf16(bflo(q.w) * sc * g1[2], bfhi(q.w) * sc * g1[3]);
            *(u32x4*)yp = o; } }
    }
    __syncthreads();
}

DI void attn_phase(unsigned char* shm, const Params& p) {
    using bf = fa::bf16; char* lds = (char*)shm; float* ckl = (float*)(lds + fa::LDS_BYTES);
    unsigned char* ws = p.ws; const bf* Q = (const bf*)(ws + OFF_QKV); const bf* K = Q + (size_t)MT * 1024; const bf* V = K + (size_t)MT * 1024;
    bf* Y = (bf*)(ws + OFF_YCAT); const float* cum = (const float*)(ws + OFF_CUM);
    const int total = 512, stride = gridDim.x; int L = bidx(); if (L >= total) return;
    auto mkref = [&](int L_, int pass) { const int k_ = L_ >> 3, bh = (k_ >> 3) * 8 + (L_ & 7), x = k_ & 7, qb = pass ? 15 - x : x, b = bh >> 3, h = bh & 7;
        fa::BlockRef<bf, bf> r; r.Q = Q + ((size_t)bh * SEQ + (size_t)qb * 256) * 128; r.K = K + (size_t)bh * SEQ * 128; r.V = V + (size_t)bh * SEQ * 128;
        r.O = Y + ((size_t)(b * SEQ + qb * 256)) * 2048 + 1024 + h * 128; r.P0 = qb * 256; return r; };
    int pass = 0; fa::BlockRef<bf, bf> cur = mkref(L, 0);
    { const float* c = cum + (size_t)(((L >> 6) << 3) + (L & 7)) * SEQ; for (int i = tidx(); i < cur.P0 + 256; i += NTHR) ckl[i] = -c[i] * fa::BSC; }
    __syncthreads();
    fa::Seam<bf> S;
    fa::causal_swa_prime<bf, bf>(cur, fa::WINDOW, lds, S);
    for (;;) {
        const bool more_pass = pass == 0, more_item = L + stride < total, last = !more_pass && !more_item;
        int passn = pass + 1, Ln = L; if (!more_pass) { passn = 0; Ln = more_item ? L + stride : L; }
        const fa::BlockRef<bf, bf> nxt = last ? cur : mkref(Ln, passn);
        fa::causal_swa_block<bf, bf>(cur, nxt, fa::SKV, fa::WINDOW, lds, S, ckl);
        if (last) break;
        cur = nxt; pass = passn; L = Ln;
        { const float* c = cum + (size_t)(((L >> 6) << 3) + (L & 7)) * SEQ; for (int i = tidx(); i < cur.P0 + 256; i += NTHR) ckl[i] = -c[i] * fa::BSC; }
        __syncthreads();
    }
    asm volatile("s_waitcnt vmcnt(0)" ::: "memory");
    __syncthreads();
}
constexpr int LDF = 132;
DI float rcpf_(float x) { return __builtin_amdgcn_rcpf(x); }
DI float fsig_(float x) { return rcpf_(1.0f + __expf(-x)); }
DI void rec_scan_phase(unsigned char* shm, const Params& p, int ri) {
    unsigned char* ws = p.ws; const int tid = tidx(), lane = tid & 63, w = __builtin_amdgcn_readfirstlane(tid >> 6), fr = lane & 15, fq = lane >> 4;
    const bf16_t* xr = (const bf16_t*)(ws + OFF_YCAT) + (size_t)MT * 1024; const bf16_t* Wg = (const bf16_t*)(ws + OFF_WG);
    bf16_t* HL = (bf16_t*)(ws + OFF_QKV); bf16_t* PP = HL + (size_t)MT * 1024;
    float* RH = (float*)(ws + OFF_RH); float* RA = (float*)(ws + OFF_RA);
    bf16_t* Xa = (bf16_t*)shm;
    float* Xf = (float*)(shm + 64 * LDT * 2);
    float* La = Xf + 64 * LDF; float* Ua = La + 64 * LDF;
    const float* cw = p.rec_conv_w + (size_t)ri * 4 * 1024; const float* cb = p.rec_conv_b + (size_t)ri * 1024;
    const int c8 = (tid & 15) * 8, l0 = (tid >> 4) * 2;
    int nb_cur = -1;
    float wv[4][8], bias[8]; bf16x8 Wa[4], Wx[4]; f32x4 ba4, bx4, ls4;
#pragma unroll
    for (int k = 0; k < 4; ++k) {
#pragma unroll
        for (int j = 0; j < 8; ++j) wv[k][j] = 0.f; Wa[k] = (bf16x8){0, 0, 0, 0, 0, 0, 0, 0}; Wx[k] = Wa[k]; }
#pragma unroll
    for (int j = 0; j < 8; ++j) bias[j] = 0.f;
    ba4 = (f32x4){0.f, 0.f, 0.f, 0.f}; bx4 = ba4; ls4 = ba4;
    u32x4 rows[5];
#define REC_FETCH(it_) do { const int nb_ = (it_) & 7, t0_ = ((it_) >> 3) * 64 + l0, s0_ = t0_ & (SEQ - 1);                    \
        _Pragma("unroll") for (int q = 0; q < 5; ++q) { rows[q] = (u32x4){0u, 0u, 0u, 0u};                                       \
            if (s0_ - 3 + q >= 0) rows[q] = *(const u32x4*)(xr + (size_t)(t0_ - 3 + q) * 1024 + nb_ * 128 + c8); } } while (0)
    int it = bidx();
    if (it < 4096) REC_FETCH(it);
    for (; it < 4096; it += gridDim.x) {
        const int nb = it & 7, chunk = it >> 3, tok0 = chunk * 64, ch0 = nb * 128;
        if (nb != nb_cur) {
            nb_cur = nb; const int c = ch0 + c8;
#pragma unroll
            for (int k = 0; k < 4; ++k) { const f32x4 a = *(const f32x4*)(cw + k * 1024 + c), b2 = *(const f32x4*)(cw + k * 1024 + c + 4);
#pragma unroll
                for (int j = 0; j < 4; ++j) { wv[k][j] = a[j]; wv[k][4 + j] = b2[j]; } }
            { const f32x4 a = *(const f32x4*)(cb + c), b2 = *(const f32x4*)(cb + c + 4);
#pragma unroll
              for (int j = 0; j < 4; ++j) { bias[j] = a[j]; bias[4 + j] = b2[j]; } }
            const bf16_t* Wb = Wg + (size_t)nb * 256 * 128;
#pragma unroll
            for (int ks = 0; ks < 4; ++ks) { Wa[ks] = *(const bf16x8*)(Wb + (16 * w + fr) * 128 + 32 * ks + 8 * fq); Wx[ks] = *(const bf16x8*)(Wb + (128 + 16 * w + fr) * 128 + 32 * ks + 8 * fq); }
            const int ch = ch0 + 16 * w + 4 * fq;
            ba4 = *(const f32x4*)(p.rec_b_a + ri * 1024 + ch); bx4 = *(const f32x4*)(p.rec_b_x + ri * 1024 + ch);
            const f32x4 lm = *(const f32x4*)(p.rec_lambda + ri * 1024 + ch);
#pragma unroll
            for (int i = 0; i < 4; ++i) ls4[i] = 8.0f * logsigf_(lm[i]);
        }
        __syncthreads();
#pragma unroll
        for (int q = 0; q < 2; ++q) { float y[8];
#pragma unroll
            for (int j = 0; j < 8; ++j) { const int jj = j >> 1;
                const float r0 = (j & 1) ? bfhi(rows[q][jj]) : bflo(rows[q][jj]), r1 = (j & 1) ? bfhi(rows[q + 1][jj]) : bflo(rows[q + 1][jj]);
                const float r2 = (j & 1) ? bfhi(rows[q + 2][jj]) : bflo(rows[q + 2][jj]), r3 = (j & 1) ? bfhi(rows[q + 3][jj]) : bflo(rows[q + 3][jj]);
                y[j] = bias[j] + wv[0][j] * r0 + wv[1][j] * r1 + wv[2][j] * r2 + wv[3][j] * r3; }
            u32x4 o; o.x = cvt_pk_bf16(y[0], y[1]); o.y = cvt_pk_bf16(y[2], y[3]); o.z = cvt_pk_bf16(y[4], y[5]); o.w = cvt_pk_bf16(y[6], y[7]);
            *(u32x4*)(Xa + (l0 + q) * LDT + c8) = o;
            *(f32x4*)(Xf + (l0 + q) * LDF + c8) = (f32x4){y[0], y[1], y[2], y[3]}; *(f32x4*)(Xf + (l0 + q) * LDF + c8 + 4) = (f32x4){y[4], y[5], y[6], y[7]}; }
        __syncthreads();
        if (it + (int)gridDim.x < 4096) REC_FETCH(it + (int)gridDim.x);
        const int cc0 = 16 * w + 4 * fq;
#pragma unroll
        for (int tt = 0; tt < 4; ++tt) { const int tl = 16 * tt + fr;
            f32x4 ar = (f32x4){0.f, 0.f, 0.f, 0.f}, ax = (f32x4){0.f, 0.f, 0.f, 0.f};
#pragma unroll
            for (int ks = 0; ks < 4; ++ks) { const bf16x8 xf_ = *(const bf16x8*)(Xa + tl * LDT + 32 * ks + 8 * fq); ar = MFMA16(Wa[ks], xf_, ar); ax = MFMA16(Wx[ks], xf_, ax); }
            const f32x4 xv = *(const f32x4*)(Xf + tl * LDF + cc0);
            f32x4 lg4, u4;
#pragma unroll
            for (int i = 0; i < 4; ++i) {
                const float r = fsig_(ar[i] + ba4[i]), ig = fsig_(ax[i] + bx4[i]), lg = ls4[i] * r;
                const float z = 2.0f * lg;
                const float om = z < -0.3f ? 1.0f - __expf(z) : -z * (1.0f + z * (0.5f + z * (0.16666667f + z * (0.041666668f + z * (0.0083333333f + z * 0.0013888889f)))));
                lg4[i] = lg; u4[i] = __builtin_amdgcn_sqrtf(fmaxf(om, 0.f)) * (ig * xv[i]); }
            *(f32x4*)(La + tl * LDF + cc0) = lg4; *(f32x4*)(Ua + tl * LDF + cc0) = u4; }
        { const int c = lane & 15, q = lane >> 4, cc = 16 * w + c;
          float h = 0.f, A = 0.f;
#pragma unroll
          for (int t = 0; t < 16; ++t) { const int o = (16 * q + t) * LDF + cc; const float lgv = La[o]; A += lgv; h = __expf(lgv) * h + Ua[o]; La[o] = A; Ua[o] = h; }
          float cin = 0.f, Ain = 0.f;
#pragma unroll
          for (int qq = 0; qq < 3; ++qq) { const float aq = __shfl(A, c + 16 * qq), hq_ = __shfl(h, c + 16 * qq); if (qq < q) { cin = __expf(aq) * cin + hq_; Ain += aq; } }
          float hl = 0.f, At = 0.f;
#pragma unroll
          for (int t = 0; t < 16; ++t) { const int o = (16 * q + t) * LDF + cc; At = La[o]; hl = Ua[o] + __expf(At) * cin; Ua[o] = hl; La[o] = __expf(At + Ain); }
          if (q == 3) { RH[(size_t)chunk * 1024 + ch0 + cc] = hl; RA[(size_t)chunk * 1024 + ch0 + cc] = At + Ain; } }
        { const int t = lane; const size_t o = (size_t)(tok0 + t) * 1024 + ch0 + 16 * w;
          u32x4 oh[2], op[2];
#pragma unroll
          for (int k = 0; k < 2; ++k) { const f32x4 h0 = *(const f32x4*)(Ua + t * LDF + 16 * w + 8 * k), h1 = *(const f32x4*)(Ua + t * LDF + 16 * w + 8 * k + 4);
              const f32x4 p0 = *(const f32x4*)(La + t * LDF + 16 * w + 8 * k), p1 = *(const f32x4*)(La + t * LDF + 16 * w + 8 * k + 4);
              oh[k].x = cvt_pk_bf16(h0[0], h0[1]); oh[k].y = cvt_pk_bf16(h0[2], h0[3]); oh[k].z = cvt_pk_bf16(h1[0], h1[1]); oh[k].w = cvt_pk_bf16(h1[2], h1[3]);
              op[k].x = cvt_pk_bf16(p0[0], p0[1]); op[k].y = cvt_pk_bf16(p0[2], p0[3]); op[k].z = cvt_pk_bf16(p1[0], p1[1]); op[k].w = cvt_pk_bf16(p1[2], p1[3]); }
          *(u32x4*)(HL + o) = oh[0]; *(u32x4*)(HL + o + 8) = oh[1]; *(u32x4*)(PP + o) = op[0]; *(u32x4*)(PP + o + 8) = op[1]; }
    }
#undef REC_FETCH
    __syncthreads();
}
DI void rec_carry_phase(const Params& p) {
    unsigned char* ws = p.ws; const float* RH = (const float*)(ws + OFF_RH); const float* RA = (const float*)(ws + OFF_RA); float* RC = (float*)(ws + OFF_RC);
    for (int idx = bidx() * NTHR + tidx(); idx < 8192; idx += gridDim.x * NTHR) {
        const int b = idx >> 10, c = idx & 1023; float carry = 0.f;
        for (int z0 = 0; z0 < 64; z0 += 16) { float a[16], h[16];
#pragma unroll
            for (int z = 0; z < 16; ++z) { const size_t o = (size_t)(b * 64 + z0 + z) * 1024 + c; a[z] = RA[o]; h[z] = RH[o]; }
#pragma unroll
            for (int z = 0; z < 16; ++z) { RC[(size_t)(b * 64 + z0 + z) * 1024 + c] = carry; carry = __expf(a[z]) * carry + h[z]; } }
    }
}
DI void rec_final_phase(const Params& p) {
    unsigned char* ws = p.ws; const bf16_t* HL = (const bf16_t*)(ws + OFF_QKV); const bf16_t* PP = HL + (size_t)MT * 1024;
    const float* RC = (const float*)(ws + OFF_RC); bf16_t* gate = (bf16_t*)(ws + OFF_YCAT);
#pragma unroll 2
    for (int idx = bidx() * NTHR + tidx(); idx < MT * 128; idx += gridDim.x * NTHR) {
        const int t = idx >> 7, c8 = (idx & 127) * 8; const size_t o = (size_t)t * 1024 + c8;
        const u32x4 hq = __builtin_nontemporal_load((const u32x4*)(HL + o)), pq = __builtin_nontemporal_load((const u32x4*)(PP + o)), gq = __builtin_nontemporal_load((const u32x4*)(gate + o));
        const f32x4 c0 = *(const f32x4*)(RC + (size_t)(t >> 6) * 1024 + c8), c1 = *(const f32x4*)(RC + (size_t)(t >> 6) * 1024 + c8 + 4);
        u32x4 r;
        r.x = cvt_pk_bf16((bflo(hq.x) + bflo(pq.x) * c0[0]) * bflo(gq.x), (bfhi(hq.x) + bfhi(pq.x) * c0[1]) * bfhi(gq.x));
        r.y = cvt_pk_bf16((bflo(hq.y) + bflo(pq.y) * c0[2]) * bflo(gq.y), (bfhi(hq.y) + bfhi(pq.y) * c0[3]) * bfhi(gq.y));
        r.z = cvt_pk_bf16((bflo(hq.z) + bflo(pq.z) * c1[0]) * bflo(gq.z), (bfhi(hq.z) + bfhi(pq.z) * c1[1]) * bfhi(gq.z));
        r.w = cvt_pk_bf16((bflo(hq.w) + bflo(pq.w) * c1[2]) * bflo(gq.w), (bfhi(hq.w) + bfhi(pq.w) * c1[3]) * bfhi(gq.w));
        *(u32x4*)(gate + o) = r;
    }
}
constexpr int STEPS = 13, NPHASE = 1 + 4 * STEPS;
DI void ffn_resnorm(const Params& p, int layer, int gi_post, float wgt, const float* gpre, int probe) {
    unsigned char* ws = p.ws;
    float* xo = probe ? (float*)(ws + OFF_QKV) : p.out; bf16_t* xn = probe ? (bf16_t*)(ws + OFF_QKV + (size_t)MT * 1024 * 4) : (bf16_t*)(ws + OFF_XN);
    resnorm_phase(p.out, (const bf16_t*)(ws + OFF_XBCP), wgt, p.norm_g + ((size_t)layer * 6 + gi_post) * DM, gpre, xo, xn);
}
#define LAUNDER(x) asm volatile("" : "+s"(x))
DI void run_phase(unsigned char* shm, const Params& pin, int ph, int probe) {
    Params p = pin;
    size_t z_ = 0; asm volatile("" : "+s"(z_));
    p.x += z_; p.norm_g += z_; p.ffn_w_in += z_; p.ffn_w_out += z_; p.hyb_w_in += z_; p.ssm_conv_w += z_; p.ssm_conv_b += z_;
    p.ssm_dt_bias += z_; p.ssm_a_log += z_; p.ssm_d += z_; p.ssm_norm_g += z_; p.fox_b_f += z_; p.hyb_w_out += z_;
    p.rec_w_in += z_; p.rec_conv_w += z_; p.rec_conv_b += z_; p.rec_w_a += z_; p.rec_b_a += z_; p.rec_w_x += z_; p.rec_b_x += z_;
    p.rec_lambda += z_; p.rec_w_out += z_; p.out += z_; p.ws += z_;
    unsigned char* ws = p.ws;
    if (ph == 0) { convert_weights(shm, p, 0); resnorm_phase(p.x, nullptr, 0.f, nullptr, p.norm_g, p.out, (bf16_t*)(ws + OFF_XN)); return; }
    const int layer = (ph - 1) / STEPS, st = (ph - 1) % STEPS, hyb = (layer & 1) == 0, mi = layer >> 1;
    const float* ng = p.norm_g + (size_t)layer * 6 * DM;
    switch (st) {
    case 0: case 10: { EpiSwiglu E; E.O = (bf16_t*)(ws + OFF_QKV);
        run_gemm(shm, (const bf16_t*)(ws + OFF_XN), (const bf16_t*)(ws + OFF_WFIN + (st ? SZ_WFIN : 0)), 5632, 1024, E); } break;
    case 1: case 11: { EpiPlain E; E.O = (bf16_t*)(ws + OFF_XBCP); E.ldc = 1024;
        run_gemm(shm, (const bf16_t*)(ws + OFF_QKV), (const bf16_t*)(ws + OFF_WFOUT + (st == 11 ? SZ_WFOUT : 0)), 1024, 2816, E); } break;
    case 2: ffn_resnorm(p, layer, 1, 0.5f, ng + 2 * DM, probe); break;
    case 3:
        if (hyb) { EpiHyb E; E.ycat = (bf16_t*)(ws + OFF_YCAT); E.xbcp = (bf16_t*)(ws + OFF_XBCP); E.qkv = (bf16_t*)(ws + OFF_QKV); E.misc = (float*)(ws + OFF_MISC);
            run_gemm(shm, (const bf16_t*)(ws + OFF_XN), (const bf16_t*)(ws + OFF_WMIN), 5888, 1024, E); }
        else { EpiRec E; E.G = (bf16_t*)(ws + OFF_YCAT); E.X = (bf16_t*)(ws + OFF_YCAT) + (size_t)MT * 1024;
            run_gemm(shm, (const bf16_t*)(ws + OFF_XN), (const bf16_t*)(ws + OFF_WMIN), 2048, 1024, E); }
        break;
    case 4: if (hyb) hyb_prep_phase(shm, p, mi); else rec_scan_phase(shm, p, mi); break;
    case 5: if (hyb) ssd_states_phase(shm, p); else rec_carry_phase(p); break;
    case 6: if (hyb) ssd_carry_phase(p); else rec_final_phase(p); break;
    case 7: if (hyb) { attn_phase(shm, p); if (!probe) ssd_out_phase(shm, p, mi); } break;
    case 8: { EpiPlain E; E.O = (bf16_t*)(ws + OFF_XBCP); E.ldc = 1024;
        if (hyb) run_gemm(shm, (const bf16_t*)(ws + OFF_YCAT), (const bf16_t*)(ws + OFF_WMOUT), 1024, 2048, E);
        else run_gemm(shm, (const bf16_t*)(ws + OFF_YCAT), (const bf16_t*)(ws + OFF_WMOUT), 1024, 1024, E); } break;
    case 9: ffn_resnorm(p, layer, 3, 1.0f, ng + 4 * DM, probe); break;
    case 12: if (layer < 3 && probe != 2) convert_weights(shm, p, layer + 1);
        if (probe != 1) ffn_resnorm(p, layer, 5, 0.5f, layer < 3 ? p.norm_g + (size_t)(layer + 1) * 6 * DM : nullptr, probe); break;
    }
}
template <int PH> DI void run_all(unsigned char* shm, const Params& p, const XcdBarrier& xbar) {
    if constexpr (PH < NPHASE) {
        constexpr bool skip = PH > 0 && (PH - 1) % STEPS == 7 && ((((PH - 1) / STEPS) & 1) != 0);
        if constexpr (!skip) { run_phase(shm, p, PH, 0); if constexpr (PH + 1 < NPHASE) xcd_barrier(xbar); }
        run_all<PH + 1>(shm, p, xbar);
    }
}
__global__ void __launch_bounds__(NTHR, 2) fwd_megakernel(Params p) {
    extern __shared__ __attribute__((aligned(16))) unsigned char shm[];
    cg::grid_group grid = cg::this_grid();
    if (p.ph_lo < 0) grid.sync();
    volatile LAS unsigned* bst = (volatile LAS unsigned*)(shm + 131072);
    if (tidx() < 4) bst[tidx()] = 0u;
    __syncthreads();
    const XcdBarrier xbar = xcd_barrier_post((unsigned*)(p.ws + OFF_BAR), bst);
#define GSYNC() xcd_barrier(xbar)
#if PROBE_CAT
    unsigned long long tacc_ = 0;
#endif
#if !PROBE_CAT && !REP_MASK && !PER_PHASE_LAUNCH
    run_all<0>(shm, p, xbar);
#else
    for (int ph = p.ph_lo; ph < p.ph_hi; ++ph) {
        if (ph > 0 && (ph - 1) % STEPS == 7 && (((ph - 1) / STEPS) & 1)) continue;
        int nrep = 0;
#if REP_MASK
        { const int layer_ = (ph - 1) / STEPS, st_ = ph ? (ph - 1) % STEPS : -1, hyb_ = (layer_ & 1) == 0;
          const bool isg = st_ == 0 || st_ == 1 || st_ == 3 || st_ == 8 || st_ == 10 || st_ == 11;
          const bool iso = (st_ == 4) || (st_ == 5);
          const bool isa = st_ == 7 && hyb_;
          if (((REP_MASK & 1) && isg) || ((REP_MASK & 4) && iso) || ((REP_MASK & 2) && isa)) nrep = 1;
          if ((REP_MASK & 8) && st_ == 12 && layer_ < 3) nrep = 1;
          if ((REP_MASK & 16) && (st_ == 2 || st_ == 9 || st_ == 12)) nrep = 2;
          if ((REP_MASK & 32) && (st_ == 4 || st_ == 5) && hyb_) nrep = 1;
          if ((REP_MASK & 64) && st_ == 4 && !hyb_) nrep = 1; }
#endif
#if PROBE_CAT
        const unsigned long long t0_ = __builtin_amdgcn_s_memrealtime();
#endif
        for (int r = nrep; r >= 0; r -= (nrep == 2 ? 2 : 1)) { run_phase(shm, p, ph, r);
#if PROBE_CAT == 7
            if (r == 1 && nrep == 1) tacc_ += __builtin_amdgcn_s_memrealtime() - t0_;
#endif
            if (r) GSYNC(); }
#if PROBE_CAT
        { const unsigned long long t1_ = __builtin_amdgcn_s_memrealtime();
          const int layer_ = (ph - 1) / STEPS, st_ = ph ? (ph - 1) % STEPS : -1, hyb_ = (layer_ & 1) == 0; int cat = 0;
          if (st_ == 0 || st_ == 1 || st_ == 3 || st_ == 8 || st_ == 10 || st_ == 11) cat = 1;
          else if (ph == 0 || st_ == 2 || st_ == 9 || st_ == 12) cat = 2;
          else if (st_ == 7) cat = 3;
          else cat = hyb_ ? 4 : 5;
          if (cat == PROBE_CAT) tacc_ += t1_ - t0_;
          if (ph + 1 < p.ph_hi) GSYNC();
          if (PROBE_CAT == 6) tacc_ += __builtin_amdgcn_s_memrealtime() - t1_;
          continue; }
#endif
        if (ph + 1 < p.ph_hi) GSYNC();
    }
#endif
#if PROBE_CAT
    if (bidx() == 0) { const unsigned long long te_ = __builtin_amdgcn_s_memrealtime(); while (__builtin_amdgcn_s_memrealtime() - te_ < 4ull * tacc_) __builtin_amdgcn_s_sleep(8); }
#endif
}

extern "C" void kernel_launch(void* const* d_in, const int* in_sizes, int n_in, void* d_out, int out_size, void* d_ws, size_t ws_size, hipStream_t stream) {
    static int grid = 0;
    if (grid == 0) {
        if (n_in != 22 || out_size != MT * DM || ws_size < WS_END) { fprintf(stderr, "kernel_launch: unexpected shapes (n_in %d out %d ws %zu need %zu)\n", n_in, out_size, ws_size, (size_t)WS_END); grid = -1; return; }
        int dev = 0, cus = 0, per_cu = 0;
        hipGetDevice(&dev); hipDeviceGetAttribute(&cus, hipDeviceAttributeMultiprocessorCount, dev);
        if (hipFuncSetAttribute((const void*)fwd_megakernel, hipFuncAttributeMaxDynamicSharedMemorySize, LDS_TOTAL) != hipSuccess) { fprintf(stderr, "kernel_launch: hipFuncSetAttribute failed\n"); grid = -1; return; }
        if (hipOccupancyMaxActiveBlocksPerMultiprocessor(&per_cu, (const void*)fwd_megakernel, NTHR, LDS_TOTAL) != hipSuccess || per_cu < 1) { fprintf(stderr, "kernel_launch: occupancy query says %d\n", per_cu); per_cu = 1; }
        (void)hipGetLastError();
        grid = cus * (per_cu > 1 ? 1 : per_cu);
        if (grid <= 0) grid = 256;
    }
    if (grid < 0) return;
    Params p{};
    const float** f = (const float**)&p;
    for (int i = 0; i < 22; ++i) f[i] = (const float*)d_in[i];
    p.out = (float*)d_out; p.ws = (unsigned char*)d_ws;
#if PER_PHASE_LAUNCH
    for (int ph = 0; ph < NPHASE; ++ph) { p.ph_lo = ph; p.ph_hi = ph + 1;
        hipLaunchKernelGGL(fwd_megakernel, dim3(grid), dim3(NTHR), LDS_TOTAL, stream, p); }
#else
    p.ph_lo = 0; p.ph_hi = NPHASE;
    if (hipMemsetAsync((unsigned char*)d_ws + OFF_BAR, 0, 16384, stream) != hipSuccess) { fprintf(stderr, "kernel_launch: memset failed\n"); return; }
    void* args[] = {&p};
    hipError_t e = hipLaunchCooperativeKernel((const void*)fwd_megakernel, dim3(grid), dim3(NTHR), args, LDS_TOTAL, stream);
    if (e != hipSuccess) fprintf(stderr, "cooperative launch failed: %s (grid %d)\n", hipGetErrorString(e), grid);
#endif
}
```

```cpp
#include <hip/hip_runtime.h>
#include <hip/hip_bf16.h>
#include <hip/hip_cooperative_groups.h>
#include <cstdio>
#include <cstdint>
namespace cg = cooperative_groups;
#ifndef REP_MASK
#define REP_MASK 0
#endif
#ifndef PROBE_CAT
#define PROBE_CAT 0
#endif
#ifndef PER_PHASE_LAUNCH
#define PER_PHASE_LAUNCH 0
#endif
__device__ __forceinline__ int tidx() { int t = threadIdx.x; asm volatile("" : "+v"(t)); return t; }
__device__ __forceinline__ int bidx() { int t = blockIdx.x; asm volatile("" : "+s"(t)); return t; }
#define XB_TMO      128
#define XB_XCNT(j)  (256  + 64 * (j))
#define XB_XSUB(j)  (1280 + 64 * (j))
#define XB_XGEN(j)  (2304 + 64 * (j))
#define XB_TOP      3328
#define XB_TOPGEN   3392
#define XCD_BAR_WORDS 3456
#define XB_SPIN_CAP (1u << 18)
#define LAS __attribute__((address_space(3)))

__device__ __forceinline__ unsigned xb_ld(unsigned* p)              { return __hip_atomic_load(p, __ATOMIC_RELAXED, __HIP_MEMORY_SCOPE_AGENT); }
__device__ __forceinline__ unsigned xb_add(unsigned* p, unsigned v) { return __hip_atomic_fetch_add(p, v, __ATOMIC_RELAXED, __HIP_MEMORY_SCOPE_AGENT); }
__device__ __forceinline__ unsigned xb_xcc_id() { return (unsigned)__builtin_amdgcn_s_getreg((3 << 11) | 20) & 0xFu; }
#define XB_SPIN(cond, bar) do { unsigned _sp = 0; while (cond) { __builtin_amdgcn_s_sleep(1); \
    if ((++_sp & 255u) == 0u) { if (xb_ld(&(bar)[XB_TMO])) break; if (_sp > XB_SPIN_CAP) { atomicAdd(&(bar)[XB_TMO], 1u); break; } } } } while (0)

struct XcdBarrier {
    unsigned* bar; unsigned x;
    volatile LAS unsigned* st;
};

__device__ __forceinline__ XcdBarrier xcd_barrier_post(unsigned* bar, volatile LAS unsigned* st) {
    XcdBarrier b; b.bar = bar; b.x = xb_xcc_id(); b.st = st;
    if (tidx() == 0) (void)xb_add(&bar[XB_XCNT(b.x)], 1u);
    return b;
}
__device__ __forceinline__ void xcd_barrier_complete(unsigned* bar, unsigned x, unsigned& nloc, unsigned& nx) {
    const unsigned G = gridDim.x * gridDim.y * gridDim.z;
    unsigned sum, cnt, mine, sp = 0u;
    for (;;) {
        sum = 0u; cnt = 0u; mine = 0u;
#pragma unroll
        for (unsigned j = 0; j < 16; ++j) { const unsigned c = xb_ld(&bar[XB_XCNT(j)]); sum += c; cnt += (c > 0u) ? 1u : 0u; mine = (j == x) ? c : mine; }
        if (sum == G) break;
        __builtin_amdgcn_s_sleep(1);
        if ((++sp & 255u) == 0u) { if (xb_ld(&bar[XB_TMO])) break; if (sp > XB_SPIN_CAP) { atomicAdd(&bar[XB_TMO], 1u); break; } }
    }
    nloc = mine > 0u ? mine : 1u; nx = cnt > 0u ? cnt : 1u;
}

__device__ __forceinline__ void xcd_barrier(const XcdBarrier& b) {
    asm volatile("s_waitcnt vmcnt(0)" ::: "memory");
    __syncthreads();
    if (tidx() == 0) {
        unsigned* bar = b.bar;
        __builtin_amdgcn_s_waitcnt(0);
        unsigned nloc = b.st[0], nx = b.st[1];
        if (nloc == 0u) { xcd_barrier_complete(bar, b.x, nloc, nx); b.st[0] = nloc; b.st[1] = nx; }
        const unsigned old = xb_add(&bar[XB_XSUB(b.x)], 1u);
        const unsigned gen = old / nloc;
        if (old + 1u == (gen + 1u) * nloc) {
            __builtin_amdgcn_fence(__ATOMIC_RELEASE, "agent");
            asm volatile("s_waitcnt vmcnt(0)" ::: "memory");
            const unsigned og = xb_add(&bar[XB_TOP], 1u);
            const unsigned tg = og / nx;
            if (og + 1u == (tg + 1u) * nx) xb_add(&bar[XB_TOPGEN], 1u);
            else XB_SPIN(xb_ld(&bar[XB_TOPGEN]) == tg, bar);
            __builtin_amdgcn_fence(__ATOMIC_ACQUIRE, "agent");
            xb_add(&bar[XB_XGEN(b.x)], 1u);
            asm volatile("s_waitcnt vmcnt(0)" ::: "memory");
        } else {
            XB_SPIN(xb_ld(&bar[XB_XGEN(b.x)]) == gen, bar);
            __builtin_amdgcn_fence(__ATOMIC_ACQUIRE, "agent");
            asm volatile("s_waitcnt vmcnt(0)" ::: "memory");
        }
    }
    __syncthreads();
}
namespace pg8 {
#define PG8_LAS __attribute__((address_space(3)))
typedef unsigned short bf16_t;
typedef short bf16x8 __attribute__((ext_vector_type(8)));
typedef float f32x4 __attribute__((ext_vector_type(4)));
typedef unsigned u32x4 __attribute__((ext_vector_type(4)));
constexpr int BM = 256, BK = 64, HALF = 128, HTB = HALF * BK * 2  , STAGE_BYTES = 8 * HTB, NXCD = 8, WGM = 8;

__host__ __device__ __forceinline__ int lds_byte(int r, int c) { const int st = (r >> 4) * 2 + (c >> 5), rr = r & 15, cc = c & 31, ob = rr * 64 + cc * 2; return st * 1024 + (ob ^ (((ob >> 9) & 1) << 5)); }
__host__ __device__ __forceinline__ void stage_rc(int b, int& R, int& C) { const int st = b / 1024, sb = b % 1024, swz = sb ^ (((sb >> 9) & 1) << 5); R = (st >> 1) * 16 + swz / 64; C = (st & 1) * 32 + (swz % 64) / 2; }
__host__ __device__ __forceinline__ int perm32(int rho) { const int n = rho >> 4, i = rho & 15; return 8 * (i >> 2) + 4 * n + (i & 3); }

struct Unit { int pm, pn; };
struct Gemm { const bf16_t* A; const bf16_t* Bt; int M, N, K; };

struct StaticOrder {
    int nM, nN, nwg, G, c;
    __host__ __device__ void init(int M, int N, int G_, int c_) { nM = M / BM; nN = N / BM; nwg = nM * nN; G = G_; c = c_; }
    __host__ __device__ bool next(int i, Unit& u) const {
        const long L = (long)i * G + c; if (L >= nwg) return false;
        int wgid = (int)L; { const int q = nwg / NXCD, r = nwg % NXCD, xcd = wgid % NXCD, off = wgid / NXCD; wgid = (xcd < r ? xcd * (q + 1) : r * (q + 1) + (xcd - r) * q) + off; }
        const int nig = WGM * nN, gid = wgid / nig, fm = gid * WGM, gsz = (nM - fm) < WGM ? (nM - fm) : WGM;
        u.pm = fm + ((wgid % nig) % gsz); u.pn = (wgid % nig) / gsz; return true;
    }
    __device__ __forceinline__ void a_ready(const Unit&) const {}
    __device__ __forceinline__ void done(const Unit&) const {}
};
typedef float f32x2c __attribute__((ext_vector_type(2)));
typedef __bf16 bf16x2c __attribute__((ext_vector_type(2)));
__device__ __forceinline__ unsigned cvt_pk_bf16(float lo, float hi) { const f32x2c v = {lo, hi}; return __builtin_bit_cast(unsigned, __builtin_convertvector(v, bf16x2c)); }

template <class Epi, class Sched, bool STAMP = false>
__device__ __forceinline__ void gemm_phase(PG8_LAS unsigned char* lds, const Gemm g, const Sched& S, const Epi& E, unsigned long long* stamps) {
    const int tid = tidx(), wid = __builtin_amdgcn_readfirstlane(tid >> 6), lane = tid & 63, wr = wid >> 2, wc = wid & 3, fr = lane & 15, fq = lane >> 4;
    const int K = g.K, nt = K / BK;
    int ts_lo = 0, ts_hi = 0, nts = 0; const unsigned long long rt_entry = STAMP ? (unsigned long long)wall_clock64() : 0ull;
#define PG8_STAMP() do { if (STAMP && wid == 0 && nts < 64) { const unsigned long long _c = (unsigned long long)clock64(); \
        ts_lo = (lane == nts) ? (int)(unsigned)_c : ts_lo; ts_hi = (lane == nts) ? (int)(unsigned)(_c >> 32) : ts_hi; ++nts; } } while (0)
    PG8_STAMP();
    unsigned voffA[2], voffB[2];
#pragma unroll
    for (int i = 0; i < 2; ++i) { int R, C; stage_rc(tid * 16 + i * 8192, R, C); const int Rb = Epi::PERM ? ((R & ~31) + perm32(R & 31)) : R;
        voffA[i] = (unsigned)(R * K + C) * 2u; voffB[i] = (unsigned)(Rb * K + C) * 2u; }
    const size_t kstep = (size_t)(BK * 2);
    const size_t hstep = (size_t)HALF * K * 2;
    const size_t tstep = 2 * hstep;
    const unsigned ldsw = (unsigned)wid * 1024u;
    const int aoff = lds_byte(wr * 64 + fr, fq * 8), boff = lds_byte(wc * 32 + fr, fq * 8);
#define PG8_SA(b, h) (((b) * 2 + (h)) * HTB)
#define PG8_SB(b, h) ((4 + (b) * 2 + (h)) * HTB)
#define PG8_STAGE(bufoff, gbase, voff) do { _Pragma("unroll") for (int _i = 0; _i < 2; ++_i) \
        __builtin_amdgcn_global_load_lds((const unsigned*)((const char*)(gbase) + (voff)[_i]), (PG8_LAS unsigned*)(lds + (bufoff) + ldsw + _i * 8192), 16, 0, 0); } while (0)
#define PG8_LDA(dst, b, h) do { _Pragma("unroll") for (int m = 0; m < 4; ++m) _Pragma("unroll") for (int k = 0; k < 2; ++k) dst[m][k] = *(const PG8_LAS bf16x8*)(lds + PG8_SA(b, h) + aoff + m * 2048 + k * 1024); } while (0)
#define PG8_LDB(dst, b, h) do { _Pragma("unroll") for (int n = 0; n < 2; ++n) _Pragma("unroll") for (int k = 0; k < 2; ++k) dst[n][k] = *(const PG8_LAS bf16x8*)(lds + PG8_SB(b, h) + boff + n * 2048 + k * 1024); } while (0)
#define PG8_MMA(ai, bj, At, Bt) do { __builtin_amdgcn_s_setprio(1); _Pragma("unroll") for (int m = 0; m < 4; ++m) _Pragma("unroll") for (int n = 0; n < 2; ++n) _Pragma("unroll") for (int k = 0; k < 2; ++k) \
        acc[ai][bj][m][n] = __builtin_amdgcn_mfma_f32_16x16x32_bf16(Bt[n][k], At[m][k], acc[ai][bj][m][n], 0, 0, 0); __builtin_amdgcn_s_setprio(0); } while (0)
#define PG8_WAIT_V(n) asm volatile("s_waitcnt vmcnt(" #n ")" ::: "memory")
#define PG8_WAIT_L(n) asm volatile("s_waitcnt lgkmcnt(" #n ")" ::: "memory")
#define PG8_BAR __builtin_amdgcn_s_barrier()
#define PG8_SCHED __builtin_amdgcn_sched_barrier(0)
    Unit cur, nxt; int ui = 0;
    if (!S.next(0, cur)) return;
    f32x4 acc[2][2][4][2];
#pragma unroll
    for (int a = 0; a < 2; ++a)
#pragma unroll
        for (int b = 0; b < 2; ++b)
#pragma unroll
            for (int m = 0; m < 4; ++m)
#pragma unroll
                for (int n = 0; n < 2; ++n) acc[a][b][m][n] = (f32x4){0.f, 0.f, 0.f, 0.f};
    bf16x8 At[4][2], B0[2][2], B1[2][2];
    const char* cA = (const char*)g.A + (size_t)cur.pm * tstep; const char* cB = (const char*)g.Bt + (size_t)cur.pn * tstep;
    S.a_ready(cur);
    PG8_STAGE(PG8_SB(0, 0), cB, voffB); PG8_STAGE(PG8_SA(0, 0), cA, voffA); PG8_STAGE(PG8_SB(0, 1), cB + hstep, voffB); PG8_STAGE(PG8_SA(0, 1), cA + hstep, voffA);
    if (wr == 1) PG8_BAR;
    PG8_WAIT_V(4); PG8_BAR;
    PG8_STAGE(PG8_SB(1, 0), cB + kstep, voffB); PG8_STAGE(PG8_SA(1, 0), cA + kstep, voffA); PG8_STAGE(PG8_SB(1, 1), cB + hstep + kstep, voffB);
    PG8_WAIT_V(6); PG8_BAR;
    PG8_STAMP();
    for (;;) {
        const bool has_next = S.next(ui + 1, nxt);
        const char* nA = has_next ? (const char*)g.A + (size_t)nxt.pm * tstep : cA; const char* nB = has_next ? (const char*)g.Bt + (size_t)nxt.pn * tstep : cB;
        for (int t = 0; t < nt; t += 2) {
            const bool last = (t == nt - 2);
            const char* a1 = cA + (size_t)(t + 1) * kstep;
            const char* a2 = last ? nA : cA + (size_t)(t + 2) * kstep; const char* b2 = last ? nB : cB + (size_t)(t + 2) * kstep;
            const char* a3 = a2 + kstep; const char* b3 = b2 + kstep;
            if (last && has_next) S.a_ready(nxt);
            PG8_LDB(B0, 0, 0); PG8_SCHED; PG8_LDA(At, 0, 0); PG8_STAGE(PG8_SA(1, 1), a1 + hstep, voffA);
            PG8_WAIT_L(8); PG8_BAR; PG8_WAIT_L(0); PG8_MMA(0, 0, At, B0); PG8_BAR; PG8_SCHED;
            PG8_LDB(B1, 0, 1); PG8_STAGE(PG8_SB(0, 0), b2, voffB);
            PG8_BAR; PG8_WAIT_L(0); PG8_MMA(0, 1, At, B1); PG8_BAR;
            PG8_LDA(At, 0, 1); PG8_STAGE(PG8_SA(0, 0), a2, voffA);
            PG8_BAR; PG8_WAIT_L(0); PG8_MMA(1, 0, At, B0); PG8_BAR; PG8_SCHED;
            PG8_STAGE(PG8_SB(0, 1), b2 + hstep, voffB);
            PG8_WAIT_V(6); PG8_BAR; PG8_MMA(1, 1, At, B1); PG8_BAR;
            PG8_LDB(B0, 1, 0); PG8_SCHED; PG8_LDA(At, 1, 0); PG8_STAGE(PG8_SA(0, 1), a2 + hstep, voffA);
            PG8_WAIT_L(8); PG8_BAR; PG8_WAIT_L(0); PG8_MMA(0, 0, At, B0); PG8_BAR; PG8_SCHED;
            PG8_LDB(B1, 1, 1); PG8_STAGE(PG8_SB(1, 0), b3, voffB);
            PG8_BAR; PG8_WAIT_L(0); PG8_MMA(0, 1, At, B1); PG8_BAR;
            PG8_LDA(At, 1, 1); PG8_STAGE(PG8_SA(1, 0), a3, voffA);
            PG8_BAR; PG8_WAIT_L(0); PG8_MMA(1, 0, At, B0); PG8_BAR; PG8_SCHED;
            PG8_STAGE(PG8_SB(1, 1), b3 + hstep, voffB);
            PG8_WAIT_V(6); PG8_BAR; PG8_MMA(1, 1, At, B1); PG8_BAR;
        }
        PG8_STAMP();
        if constexpr (!Epi::AFTER_DRAIN) { E(acc, cur, wr, wc, fr, fq); S.done(cur); }
        PG8_STAMP();
        if (!has_next) break;
#pragma unroll
        for (int a = 0; a < 2; ++a)
#pragma unroll
            for (int b = 0; b < 2; ++b)
#pragma unroll
                for (int m = 0; m < 4; ++m)
#pragma unroll
                    for (int n = 0; n < 2; ++n) acc[a][b][m][n] = (f32x4){0.f, 0.f, 0.f, 0.f};
        cur = nxt; cA = nA; cB = nB; ++ui;
    }
    PG8_WAIT_V(0);
    if (wr == 0) PG8_BAR;
    PG8_BAR;
    if constexpr (Epi::AFTER_DRAIN) { E.fused(acc, cur, wr, wc, fr, fq, lds, wid, lane); S.done(cur); }
    PG8_STAMP();
    if (STAMP && wid == 0) { stamps[lane] = lane < nts ? (((unsigned long long)(unsigned)ts_hi << 32) | (unsigned)ts_lo) : 0ull;
        if (lane == 62) stamps[62] = rt_entry; if (lane == 63) stamps[63] = (unsigned long long)wall_clock64(); }
#undef PG8_STAMP
#undef PG8_SA
#undef PG8_SB
#undef PG8_STAGE
#undef PG8_LDA
#undef PG8_LDB
#undef PG8_MMA
#undef PG8_WAIT_V
#undef PG8_WAIT_L
#undef PG8_BAR
#undef PG8_SCHED
}
}
namespace fa {
using TIN = __hip_bfloat16; using TOUT = __hip_bfloat16;
constexpr int B = 8, H = 8, HKV = 8, SQ = 4096, SKV = 4096, D = 128;
constexpr int QOFF = 0; constexpr int WINDOW = SKV; constexpr float THR = 8.f;
constexpr bool WSKIP = false;
constexpr int OSTR = 2048;
constexpr float BSC = 11.313708498984761f;
constexpr float SCALE = 0.08838834764831845f;
constexpr int NW = 8, QBLK = 32, KVBLK = 64, QB = NW * QBLK;
constexpr int SHM_V = KVBLK * D * 2, SHM_K = KVBLK * D * 2;
constexpr int LDS_BYTES = 2 * SHM_V + 2 * SHM_K + NW * 64 * 4;
static_assert(D == 128 && SQ % QB == 0 && SKV % KVBLK == 0 && H % HKV == 0 && QOFF >= 0 && QOFF + SQ <= SKV && WINDOW >= 1, "geometry");

using bf16 = __hip_bfloat16;
typedef short bf16x8 __attribute__((ext_vector_type(8)));
typedef short s16x4 __attribute__((ext_vector_type(4)));
typedef float f32x16 __attribute__((ext_vector_type(16)));
typedef float f32x4 __attribute__((ext_vector_type(4)));
typedef unsigned u32x4 __attribute__((ext_vector_type(4)));
template <class A, class Bt> struct same_t { static constexpr bool v = false; };
template <class A> struct same_t<A, A> { static constexpr bool v = true; };

#define KSWZ(row, colB) ((row) * 256 + ((colB) ^ (((row) & 7) << 4)))
#define SBAR() __builtin_amdgcn_sched_barrier(0)
__device__ __forceinline__ int v_st(int k, int c) { const int kk = (k & ~0xC) | ((k & 4) << 1) | ((k & 8) >> 1); return ((kk >> 3) * 4 + (c >> 5)) * 512 + ((kk & 7) * 32 + (c & 31)) * 2; }
__device__ __forceinline__ int v_rd_base(int lane) { return ((lane & 3) << 3) | (((lane >> 2) & 3) << 6) | (((lane >> 4) & 1) << 5) | (((lane >> 5) & 1) << 8); }
constexpr int v_rd_off(int d0, int ks, int half) { return d0 * 512 + ks * 4096 + half * 2048; }
__device__ __forceinline__ int crow(int r, int hi) { return (r & 3) + 8 * (r >> 2) + 4 * hi; }
__device__ __forceinline__ unsigned cvtpk(float lo, float hi) {
    unsigned r; asm volatile("v_cvt_pk_bf16_f32 %0, %1, %2" : "=v"(r) : "v"(lo), "v"(hi)); return r;
}
__device__ __forceinline__ bf16x8 pack8(f32x4 a, f32x4 b) {
    u32x4 w = {cvtpk(a[0], a[1]), cvtpk(a[2], a[3]), cvtpk(b[0], b[1]), cvtpk(b[2], b[3])};
    return *reinterpret_cast<bf16x8*>(&w);
}
template <class T> __device__ __forceinline__ bf16x8 load8(const T* p) {
    if constexpr (same_t<T, float>::v) { return pack8(*(const f32x4*)p, *(const f32x4*)(p + 4)); }
    else { return *reinterpret_cast<const bf16x8*>(p); }
}
__device__ __forceinline__ void mask_tile(f32x16& p0, f32x16& p1, int dq, unsigned W) {
    const float NEG = -__builtin_inff();
#pragma unroll
    for (int r = 0; r < 16; ++r) {
        const int c = (r & 3) + 8 * (r >> 2);
        if ((unsigned)(dq - c) >= W) p0[r] = NEG;
        if ((unsigned)(dq - c - 32) >= W) p1[r] = NEG;
    }
}
__device__ __forceinline__ void partialSM(f32x16& p0, f32x16& p1, float& m_reg, float& mn, float& alpha) {
    float pmax = p0[0]; for (int r = 1; r < 16; ++r) pmax = fmaxf(pmax, p0[r]); for (int r = 0; r < 16; ++r) pmax = fmaxf(pmax, p1[r]);
    { auto rr = __builtin_amdgcn_permlane32_swap(__float_as_uint(pmax), __float_as_uint(pmax), false, false);
      pmax = fmaxf(__uint_as_float(rr[0]), __uint_as_float(rr[1])); }
    constexpr float C2 = 1.4426950408889634f * SCALE;
    if (__builtin_expect(__all((pmax - m_reg) * SCALE <= THR), 1)) { mn = m_reg; alpha = 1.f; }
    else { mn = fmaxf(m_reg, pmax); alpha = __builtin_amdgcn_exp2f((m_reg - mn) * C2); m_reg = mn; }
    const float mnL = -mn * C2;
    for (int r = 0; r < 16; ++r) p0[r] = fmaf(p0[r], C2, mnL); for (int r = 0; r < 16; ++r) p1[r] = fmaf(p1[r], C2, mnL);
    for (int r = 0; r < 16; ++r) p0[r] = __builtin_amdgcn_exp2f(p0[r]);
}
__device__ __forceinline__ void finishSM(f32x16& p0, f32x16& p1, float alpha, float& l_reg, bf16x8& pa0, bf16x8& pa1, bf16x8& pa2, bf16x8& pa3) {
    for (int r = 0; r < 16; ++r) p1[r] = __builtin_amdgcn_exp2f(p1[r]);
    float ps = 0; for (int r = 0; r < 16; ++r) ps += p0[r]; for (int r = 0; r < 16; ++r) ps += p1[r];
    { auto rr = __builtin_amdgcn_permlane32_swap(__float_as_uint(ps), __float_as_uint(ps), false, false);
      ps = __uint_as_float(rr[0]) + __uint_as_float(rr[1]); }
    l_reg = l_reg * alpha + ps;
#define PK4(P, B_, OUT) do { unsigned a0 = cvtpk(P[B_+0], P[B_+1]), a1 = cvtpk(P[B_+2], P[B_+3]);                          \
        unsigned b0 = cvtpk(P[B_+4], P[B_+5]), b1 = cvtpk(P[B_+6], P[B_+7]);                                             \
        auto r0 = __builtin_amdgcn_permlane32_swap(a0, b0, false, false); auto r1 = __builtin_amdgcn_permlane32_swap(a1, b1, false, false); \
        u32x4 w = {r0[0], r1[0], r0[1], r1[1]}; OUT = *reinterpret_cast<bf16x8*>(&w); } while (0)
    PK4(p0, 0, pa0); PK4(p0, 8, pa1); PK4(p1, 0, pa2); PK4(p1, 8, pa3);
#undef PK4
}
template <int KB, bool SK>
__device__ __forceinline__ void qkt(f32x16& p0, f32x16& p1, const char* K_lds, int r32, int hi, const bf16x8* qr, bool act, const float* cb) {
    if (SK && !act) { const float NEG = -__builtin_inff();
#pragma unroll
        for (int r = 0; r < 16; ++r) { p0[r] = NEG; p1[r] = NEG; } return; }
#pragma unroll
    for (int r4 = 0; r4 < 4; ++r4) { const f32x4 c0_ = *(const f32x4*)(cb + 8 * r4), c1_ = *(const f32x4*)(cb + 32 + 8 * r4);
#pragma unroll
        for (int i_ = 0; i_ < 4; ++i_) { p0[4 * r4 + i_] = c0_[i_]; p1[4 * r4 + i_] = c1_[i_]; } }
    const char* kb[4];
#pragma unroll
    for (int dd = 0; dd < 4; ++dd) kb[dd] = K_lds + KB * SHM_K + KSWZ(r32, (dd * 16 + hi * 8) * 2);
#pragma unroll
    for (int d0 = 0; d0 < 8; ++d0) { const char* a = kb[d0 & 3] + (d0 >> 2) * 128;
        bf16x8 b0 = *reinterpret_cast<const bf16x8*>(a);
        bf16x8 b1 = *reinterpret_cast<const bf16x8*>(a + 32 * 256);
        p0 = __builtin_amdgcn_mfma_f32_32x32x16_bf16(b0, qr[d0], p0, 0, 0, 0);
        p1 = __builtin_amdgcn_mfma_f32_32x32x16_bf16(b1, qr[d0], p1, 0, 0, 0); }
}
template <int VB, bool SK>
__device__ __forceinline__ void pv_tile(f32x16* o, int vb0, bf16x8 pa0, bf16x8 pa1, bf16x8 pa2, bf16x8 pa3, bool act) {
    if (SK && !act) return;
#define TRRD(dst, off) asm volatile("ds_read_b64_tr_b16 %0, %1 offset:%2" : "=&v"(dst) : "v"(vb0), "i"(off) : "memory")
#define PV_D0(d0) do { s16x4 l0, l1, l2, l3, h0, h1, h2, h3; constexpr int b_ = VB * SHM_V + v_rd_off(d0, 0, 0);     \
        TRRD(l0, b_); TRRD(h0, b_ + 2048); TRRD(l1, b_ + 4096); TRRD(h1, b_ + 6144); TRRD(l2, b_ + 8192); TRRD(h2, b_ + 10240); TRRD(l3, b_ + 12288); TRRD(h3, b_ + 14336); \
        asm volatile("s_waitcnt lgkmcnt(0)" ::: "memory"); SBAR();                 \
        o[d0] = __builtin_amdgcn_mfma_f32_32x32x16_bf16(pa0, (bf16x8){l0[0], l0[1], l0[2], l0[3], h0[0], h0[1], h0[2], h0[3]}, o[d0], 0, 0, 0);   \
        o[d0] = __builtin_amdgcn_mfma_f32_32x32x16_bf16(pa1, (bf16x8){l1[0], l1[1], l1[2], l1[3], h1[0], h1[1], h1[2], h1[3]}, o[d0], 0, 0, 0);   \
        o[d0] = __builtin_amdgcn_mfma_f32_32x32x16_bf16(pa2, (bf16x8){l2[0], l2[1], l2[2], l2[3], h2[0], h2[1], h2[2], h2[3]}, o[d0], 0, 0, 0);   \
        o[d0] = __builtin_amdgcn_mfma_f32_32x32x16_bf16(pa3, (bf16x8){l3[0], l3[1], l3[2], l3[3], h3[0], h3[1], h3[2], h3[3]}, o[d0], 0, 0, 0); } while (0)
    PV_D0(0); PV_D0(1); PV_D0(2); PV_D0(3);
#undef PV_D0
#undef TRRD
}

template <class TIn, class TOut> struct BlockRef { const TIn* Q; const TIn* K; const TIn* V; TOut* O; int P0; };
template <class TIn> struct Seam {
    bf16x8 qr[8];
    bf16x8 st_v0, st_v1, st_k0, st_k1; f32x4 sf0, sf1, sf2, sf3;
    f32x4 tq[16];
};
__device__ __forceinline__ int swa_jlo(int P0, int W) { const int lowk = P0 - W + 1; return lowk > 0 ? lowk / KVBLK : 0; }
#define ROW(p, k0, rr) ((p) + (size_t)((k0) + (rr)) * D + sc)
#define VMW() asm volatile("s_waitcnt vmcnt(0)" ::: "memory")
#define VMWN(n) asm volatile("s_waitcnt vmcnt(%0)" :: "i"(n) : "memory")
#define SLOAD_H(Kp, Vp, k0) do { S.st_v0 = load8<TIn>(ROW(Vp, k0, sr)); S.st_v1 = load8<TIn>(ROW(Vp, k0, 32 + sr));              \
                         S.st_k0 = load8<TIn>(ROW(Kp, k0, sr)); S.st_k1 = load8<TIn>(ROW(Kp, k0, 32 + sr)); } while (0)
#define SWRITE_HK(bf) do { *(bf16x8*)(K_lds + (bf) * SHM_K + kws) = S.st_k0; *(bf16x8*)(K_lds + (bf) * SHM_K + kws + 32 * 256) = S.st_k1; } while (0)
#define SWRITE_HV(bf) do { *(bf16x8*)(V_lds + (bf) * SHM_V + vst0) = S.st_v0; *(bf16x8*)(V_lds + (bf) * SHM_V + vst1) = S.st_v1; } while (0)
#define SWRITE_H(bf) do { SWRITE_HV(bf); SWRITE_HK(bf); } while (0)
#define SLOAD_F(p, k0) do { S.sf0 = *(const f32x4*)ROW(p, k0, sr); S.sf1 = *(const f32x4*)(ROW(p, k0, sr) + 4);                \
                            S.sf2 = *(const f32x4*)ROW(p, k0, 32 + sr); S.sf3 = *(const f32x4*)(ROW(p, k0, 32 + sr) + 4); } while (0)
#define SWRITE_KF(bf) do { *(bf16x8*)(K_lds + (bf) * SHM_K + kws) = pack8(S.sf0, S.sf1); *(bf16x8*)(K_lds + (bf) * SHM_K + kws + 32 * 256) = pack8(S.sf2, S.sf3); } while (0)
#define SWRITE_VF(bf) do { *(bf16x8*)(V_lds + (bf) * SHM_V + vst0) = pack8(S.sf0, S.sf1); *(bf16x8*)(V_lds + (bf) * SHM_V + vst1) = pack8(S.sf2, S.sf3); } while (0)
template <class TIn, class TOut>
__device__ __forceinline__ void causal_swa_prime(const BlockRef<TIn, TOut>& cur, int W, char* lds, Seam<TIn>& S) {
    constexpr bool F32 = same_t<TIn, float>::v;
    const int tid = tidx(), wid = __builtin_amdgcn_readfirstlane(tid >> 6), lane = tid & 63, r32 = lane & 31, hi = lane >> 5;
    const int sr = tid >> 4, sc = (tid & 15) * 8, kws = KSWZ(sr, sc * 2); char* K_lds = lds + 2 * SHM_V;
    const int kb0 = swa_jlo(cur.P0, W) * KVBLK;
    for (int d0 = 0; d0 < 8; ++d0) S.qr[d0] = load8<TIn>(cur.Q + (size_t)(wid * QBLK + r32) * D + d0 * 16 + hi * 8);
    if constexpr (F32) { SLOAD_F((const float*)cur.K, kb0); VMW(); SWRITE_KF(0); SBAR(); SLOAD_F((const float*)cur.V, kb0); }
    else { SLOAD_H(cur.K, cur.V, kb0); VMW(); SWRITE_HK(0); }
    __syncthreads();
}
template <class TIn, class TOut>
__device__ __forceinline__ void causal_swa_block(const BlockRef<TIn, TOut>& cur, const BlockRef<TIn, TOut>& nxt, int skv, int W, char* lds, Seam<TIn>& S, const float* ckl) {
    constexpr bool F32 = same_t<TIn, float>::v;
    const int tid = tidx(), wid = __builtin_amdgcn_readfirstlane(tid >> 6), lane = tid & 63, r32 = lane & 31, hi = lane >> 5;
    const int j_lo = swa_jlo(cur.P0, W);
    int j_hi = (cur.P0 + QB - 1) / KVBLK + 1; if (j_hi > skv / KVBLK) j_hi = skv / KVBLK;
    const int NT = j_hi - j_lo;
    const int kbn = swa_jlo(nxt.P0, W) * KVBLK;
    const int qlo = cur.P0 + wid * QBLK, qm = qlo + r32 - 4 * hi;
    char* V_lds = lds; char* K_lds = lds + 2 * SHM_V;
    float* ws = (float*)(lds + 2 * SHM_V + 2 * SHM_K) + wid * 64; float* li_l = ws, * al_l = ws + 32;
    float m_reg = -1e30f, l_reg = 0; f32x16 o[4] = {};
    const int sr = tid >> 4, sc = (tid & 15) * 8, vst0 = v_st(sr, sc), vst1 = v_st(32 + sr, sc), kws = KSWZ(sr, sc * 2);
    const int vb0 = (int)(uintptr_t)V_lds + v_rd_base(lane);
    const TIn* Kh = cur.K; const TIn* Vh = cur.V;
#define RESC(a) do { if (__any((a) < 1.f)) { if (hi == 0) al_l[r32] = (a); asm volatile("s_waitcnt lgkmcnt(0)" ::: "memory");              \
                     for (int d_ = 0; d_ < 4; ++d_) for (int r = 0; r < 16; ++r) o[d_][r] *= al_l[crow(r, hi)]; } } while (0)
#define KBASE(t) ((j_lo + (t)) * KVBLK)
#define ACT(t) (KBASE(t) <= qlo + QBLK - 1 && KBASE(t) + KVBLK - 1 >= qlo - W + 1)
#define MASKT(P0_, P1_, t) do { const int kb_ = KBASE(t); if ((!SK || ACT(t)) && (kb_ + KVBLK - 1 > qlo || kb_ <= qlo + QBLK - 1 - W)) mask_tile(P0_, P1_, qm - kb_, (unsigned)W); } while (0)
    constexpr int NQL = F32 ? 16 : 8;
    constexpr bool SK = WSKIP && !F32;
#define SEAM_K0() do { VMWN(NQL); if constexpr (F32) { SWRITE_KF(0); SBAR(); SLOAD_F((const float*)nxt.V, kbn); } else { SWRITE_HK(0); } SBAR(); } while (0)
    f32x16 pA0, pA1, pB0, pB1; float mnA, mnB, alA, alB; bf16x8 pa0, pa1, pa2, pa3;
    if constexpr (F32) { VMW(); SWRITE_VF(0); SBAR(); } else { SWRITE_HV(0); SBAR(); }
    if (NT > 1) { if constexpr (F32) SLOAD_F((const float*)Kh, KBASE(1)); else SLOAD_H(Kh, Vh, KBASE(1)); }
    SBAR(); qkt<0, SK>(pA0, pA1, K_lds, r32, hi, S.qr, ACT(0), ckl + KBASE(0) + 4 * hi);
    if constexpr (F32) { if (NT > 1) { VMW(); SWRITE_KF(1); SBAR(); SLOAD_F((const float*)Vh, KBASE(1)); } }
    MASKT(pA0, pA1, 0); partialSM(pA0, pA1, m_reg, mnA, alA);
    if (NT > 1) { VMW(); if constexpr (F32) { SWRITE_VF(1); SBAR(); if (NT > 2) SLOAD_F((const float*)Kh, KBASE(2)); } else SWRITE_H(1); }
    __syncthreads();
#define HALF_STEP(PX0, PX1, mnX, alX, PY0, PY1, alY, t, KB, VB, SB) do {                                                      \
        SBAR(); qkt<KB, SK>(PX0, PX1, K_lds, r32, hi, S.qr, ACT(t), ckl + KBASE(t) + 4 * hi);                                             \
        finishSM(PY0, PY1, alY, l_reg, pa0, pa1, pa2, pa3); SBAR();                                                           \
        if ((t) + 1 < NT) { if constexpr (F32) { VMW(); SWRITE_KF(SB); SBAR(); SLOAD_F((const float*)Vh, KBASE((t) + 1)); }  \
                            else { SLOAD_H(Kh, Vh, KBASE((t) + 1)); } SBAR(); }                                               \
        pv_tile<VB, SK>(o, vb0, pa0, pa1, pa2, pa3, ACT((t) - 1)); MASKT(PX0, PX1, (t)); partialSM(PX0, PX1, m_reg, mnX, alX);                                        \
        __syncthreads();                                                                                                      \
        if ((t) + 1 < NT) { VMW(); if constexpr (F32) { SWRITE_VF(SB); SBAR(); if ((t) + 2 < NT) SLOAD_F((const float*)Kh, KBASE((t) + 2)); } \
                            else { SWRITE_H(SB); } }                                                                          \
        RESC(alX); __syncthreads(); } while (0)
    for (int t = 1; t + 1 < NT; t += 2) {
        HALF_STEP(pB0, pB1, mnB, alB, pA0, pA1, alA, t, 1, 0, 0);
        HALF_STEP(pA0, pA1, mnA, alA, pB0, pB1, alB, t + 1, 0, 1, 1);
    }
    const bool even = (NT & 1) == 0;
    if (even) { SBAR(); qkt<1, SK>(pB0, pB1, K_lds, r32, hi, S.qr, ACT(NT - 1), ckl + KBASE(NT - 1) + 4 * hi); SBAR(); }
#define QROW(e) (nxt.Q + (size_t)(wid * QBLK + r32) * D + ((e) >> 1) * 16 + hi * 8 + ((e) & 1) * 4)
    if constexpr (F32) { SLOAD_F((const float*)nxt.K, kbn); SBAR();
#pragma unroll
        for (int e = 0; e < 8; ++e) S.tq[e] = *(const f32x4*)QROW(e); }
    else { SLOAD_H(nxt.K, nxt.V, kbn); SBAR();
#pragma unroll
        for (int d0 = 0; d0 < 8; ++d0) S.qr[d0] = load8<TIn>(nxt.Q + (size_t)(wid * QBLK + r32) * D + d0 * 16 + hi * 8); }
    SBAR();
    finishSM(pA0, pA1, alA, l_reg, pa0, pa1, pa2, pa3); SBAR();
    if constexpr (F32) {
#pragma unroll
        for (int e = 8; e < 16; ++e) S.tq[e] = *(const f32x4*)QROW(e); SBAR(); }
#undef QROW
    pv_tile<0, SK>(o, vb0, pa0, pa1, pa2, pa3, ACT(even ? NT - 2 : NT - 1));
    if (even) { MASKT(pB0, pB1, NT - 1); partialSM(pB0, pB1, m_reg, mnB, alB); __syncthreads(); RESC(alB);
        finishSM(pB0, pB1, alB, l_reg, pa0, pa1, pa2, pa3); SBAR(); pv_tile<1, SK>(o, vb0, pa0, pa1, pa2, pa3, ACT(NT - 1)); }
    SBAR(); SEAM_K0();
    if (hi == 0) li_l[r32] = l_reg; asm volatile("s_waitcnt lgkmcnt(0)" ::: "memory");
    float rli[16];
#pragma unroll
    for (int r = 0; r < 16; ++r) rli[r] = __builtin_amdgcn_rcpf(li_l[crow(r, hi)]);
    TOut* Ow = cur.O + (size_t)(wid * QBLK) * OSTR;
#pragma unroll
    for (int r = 0; r < 16; ++r) { const int orow = crow(r, hi);
#pragma unroll
        for (int d0 = 0; d0 < 4; ++d0) { const float v = o[d0][r] * rli[r];
            if constexpr (same_t<TOut, float>::v) { Ow[(size_t)orow * OSTR + d0 * 32 + r32] = v; }
            else { const float vn = __shfl_xor(v, 1);
                   if ((r32 & 1) == 0) *(unsigned*)(Ow + (size_t)orow * OSTR + d0 * 32 + r32) = cvtpk(v, vn); } } }
    if constexpr (F32) {
#pragma unroll
        for (int d0 = 0; d0 < 8; ++d0) S.qr[d0] = pack8(S.tq[2 * d0], S.tq[2 * d0 + 1]); }
    __syncthreads();
#undef RESC
#undef KBASE
#undef ACT
#undef MASKT
#undef SEAM_K0
#undef HALF_STEP
}
#undef ROW
#undef VMW
#undef VMWN
#undef SLOAD_H
#undef SWRITE_HK
#undef SWRITE_HV
#undef SWRITE_H
#undef SLOAD_F
#undef SWRITE_KF
#undef SWRITE_VF

}
#define DI __device__ __forceinline__
typedef unsigned short bf16_t;
typedef short bf16x8 __attribute__((ext_vector_type(8)));
typedef float f32x4 __attribute__((ext_vector_type(4)));
typedef unsigned u32x4 __attribute__((ext_vector_type(4)));
typedef unsigned u32x2 __attribute__((ext_vector_type(2)));
using pg8::cvt_pk_bf16;
constexpr int MT = 32768, DM = 1024, SEQ = 4096, NBAT = 8, DFF = 2816, NTHR = 512;
constexpr float EPS = 1e-6f;
constexpr int LDS_TOTAL = 131072 + 64;

constexpr size_t SZ_WFIN = 5632ull * 1024 * 2, SZ_WFOUT = 1024ull * 2816 * 2;
constexpr size_t OFF_WFIN = 0;
constexpr size_t OFF_WFOUT = 2 * SZ_WFIN;
constexpr size_t OFF_WMIN = OFF_WFOUT + 2 * SZ_WFOUT;
constexpr size_t OFF_WMOUT = OFF_WMIN + 5888ull * 1024 * 2;
constexpr size_t OFF_WG = OFF_WMOUT + 1024ull * 2048 * 2;
constexpr size_t OFF_YCAT = OFF_WG + 8ull * 256 * 128 * 2;
constexpr size_t OFF_XBCP = OFF_YCAT + (size_t)MT * 2048 * 2;
constexpr size_t OFF_QKV = OFF_XBCP + (size_t)MT * 1536 * 2;
constexpr size_t OFF_ST = OFF_QKV + 3ull * MT * 1024 * 2;
constexpr size_t OFF_XN = OFF_ST + (size_t)MT * 1024 * 2;
constexpr size_t OFF_MISC = OFF_XN + (size_t)MT * 1536 * 2;
constexpr size_t OFF_CUM = OFF_MISC + (size_t)MT * 32 * 4;
constexpr size_t OFF_DT = OFF_CUM + 64ull * 4096 * 4;
constexpr size_t OFF_ACS = OFF_DT + (size_t)MT * 16 * 4;
constexpr size_t OFF_RH = OFF_ACS + (size_t)MT * 16 * 4;
constexpr size_t OFF_RA = OFF_RH + 8ull * 64 * 1024 * 4;
constexpr size_t OFF_RC = OFF_RA + 8ull * 64 * 1024 * 4;
constexpr size_t OFF_BAR = OFF_RC + 8ull * 64 * 1024 * 4;
constexpr size_t WS_END = OFF_BAR + 16384;

struct Params {
    const float* x; const float* norm_g; const float* ffn_w_in; const float* ffn_w_out; const float* hyb_w_in; const float* ssm_conv_w; const float* ssm_conv_b;
    const float* ssm_dt_bias; const float* ssm_a_log; const float* ssm_d; const float* ssm_norm_g; const float* fox_b_f; const float* hyb_w_out;
    const float* rec_w_in; const float* rec_conv_w; const float* rec_conv_b; const float* rec_w_a; const float* rec_b_a; const float* rec_w_x; const float* rec_b_x;
    const float* rec_lambda; const float* rec_w_out;
    float* out; unsigned char* ws; int ph_lo, ph_hi;
};

DI bf16_t f2bf(float f) { unsigned u = __float_as_uint(f); u += 0x7FFFu + ((u >> 16) & 1u); return (bf16_t)(u >> 16); }
DI float bf2f(bf16_t b) { return __uint_as_float(((unsigned)b) << 16); }
DI float bflo(unsigned w) { return __uint_as_float(w << 16); }
DI float bfhi(unsigned w) { return __uint_as_float(w & 0xFFFF0000u); }
DI float sigmoidf_(float x) { return 1.0f / (1.0f + __expf(-x)); }
DI float siluf_(float x) { return x * __builtin_amdgcn_rcpf(1.0f + __expf(-x)); }
DI float softplusf_(float x) { return x > 20.f ? x : log1pf(__expf(x)); }
DI float logsigf_(float x) { return fminf(x, 0.f) - log1pf(__expf(-fabsf(x))); }
DI float geluf_(float x) { const float t = 1.5957691216057308f * (x + 0.044715f * x * x * x); return x * __builtin_amdgcn_rcpf(1.0f + __expf(-t)); }
#define MFMA16(a, b, c) __builtin_amdgcn_mfma_f32_16x16x32_bf16((a), (b), (c), 0, 0, 0)

struct EpiPlain {
    static constexpr bool PERM = true, AFTER_DRAIN = false;
    bf16_t* O; int ldc;
    DI void operator()(const pg8::f32x4 (&acc)[2][2][4][2], const pg8::Unit& u, int wr, int wc, int fr, int fq) const {
        const int row0 = u.pm * 256 + wr * 64 + fr, col0 = u.pn * 256 + wc * 32 + 8 * fq;
#pragma unroll
        for (int ai = 0; ai < 2; ++ai)
#pragma unroll
            for (int m = 0; m < 4; ++m) { bf16_t* rowp = O + (size_t)(row0 + ai * 128 + m * 16) * ldc + col0;
#pragma unroll
                for (int bj = 0; bj < 2; ++bj) { const pg8::f32x4 v0 = acc[ai][bj][m][0], v1 = acc[ai][bj][m][1];
                    u32x4 w; w.x = cvt_pk_bf16(v0[0], v0[1]); w.y = cvt_pk_bf16(v0[2], v0[3]); w.z = cvt_pk_bf16(v1[0], v1[1]); w.w = cvt_pk_bf16(v1[2], v1[3]);
                    *(u32x4*)(rowp + bj * 128) = w; } }
    }
};
struct EpiSwiglu {
    static constexpr bool PERM = true, AFTER_DRAIN = false;
    bf16_t* O;
    DI void operator()(const pg8::f32x4 (&acc)[2][2][4][2], const pg8::Unit& u, int wr, int wc, int fr, int fq) const {
        const int row0 = u.pm * 256 + wr * 64 + fr, col0 = u.pn * 128 + wc * 32 + 8 * fq;
#pragma unroll
        for (int ai = 0; ai < 2; ++ai)
#pragma unroll
            for (int m = 0; m < 4; ++m) { bf16_t* rowp = O + (size_t)(row0 + ai * 128 + m * 16) * DFF + col0;
                float h[8];
#pragma unroll
                for (int n = 0; n < 2; ++n)
#pragma unroll
                    for (int j = 0; j < 4; ++j) h[n * 4 + j] = siluf_(acc[ai][0][m][n][j]) * acc[ai][1][m][n][j];
                u32x4 w; w.x = cvt_pk_bf16(h[0], h[1]); w.y = cvt_pk_bf16(h[2], h[3]); w.z = cvt_pk_bf16(h[4], h[5]); w.w = cvt_pk_bf16(h[6], h[7]);
                *(u32x4*)rowp = w; }
    }
};
struct EpiHyb {
    static constexpr bool PERM = true, AFTER_DRAIN = false;
    bf16_t* ycat; bf16_t* xbcp; bf16_t* qkv; float* misc;
    DI void operator()(const pg8::f32x4 (&acc)[2][2][4][2], const pg8::Unit& u, int wr, int wc, int fr, int fq) const {
        const int row0 = u.pm * 256 + wr * 64 + fr, pn = u.pn;
        if (pn == 22) {
            if (wc == 0) {
#pragma unroll
                for (int ai = 0; ai < 2; ++ai)
#pragma unroll
                    for (int m = 0; m < 4; ++m) { float* rowp = misc + (size_t)(row0 + ai * 128 + m * 16) * 32 + 8 * fq;
                        *(pg8::f32x4*)rowp = acc[ai][0][m][0]; *(pg8::f32x4*)(rowp + 4) = acc[ai][0][m][1]; }
            }
            return;
        }
#pragma unroll
        for (int ai = 0; ai < 2; ++ai)
#pragma unroll
            for (int m = 0; m < 4; ++m) { const int r = row0 + ai * 128 + m * 16;
#pragma unroll
                for (int bj = 0; bj < 2; ++bj) { const pg8::f32x4 v0 = acc[ai][bj][m][0], v1 = acc[ai][bj][m][1];
                    u32x4 w; w.x = cvt_pk_bf16(v0[0], v0[1]); w.y = cvt_pk_bf16(v0[2], v0[3]); w.z = cvt_pk_bf16(v1[0], v1[1]); w.w = cvt_pk_bf16(v1[2], v1[3]);
                    const int cl = bj * 128 + wc * 32 + 8 * fq;
                    bf16_t* dst;
                    if (pn < 4) dst = ycat + (size_t)r * 2048 + pn * 256 + cl;
                    else if (pn < 10) dst = xbcp + (size_t)r * 1536 + (pn - 4) * 256 + cl;
                    else { const int t = (pn - 10) >> 2, head = ((pn - 10) & 3) * 2 + bj, b = r >> 12, s = r & 4095;
                        dst = qkv + (size_t)t * ((size_t)MT * 1024) + ((size_t)(b * 8 + head) * SEQ + s) * 128 + wc * 32 + 8 * fq; }
                    *(u32x4*)dst = w; } }
    }
};
struct EpiRec {
    static constexpr bool PERM = true, AFTER_DRAIN = false;
    bf16_t* G; bf16_t* X;
    DI void operator()(const pg8::f32x4 (&acc)[2][2][4][2], const pg8::Unit& u, int wr, int wc, int fr, int fq) const {
        const int row0 = u.pm * 256 + wr * 64 + fr; const bool isg = u.pn < 4;
        bf16_t* base = (isg ? G : X) + (u.pn & 3) * 256 + wc * 32 + 8 * fq;
#pragma unroll
        for (int ai = 0; ai < 2; ++ai)
#pragma unroll
            for (int m = 0; m < 4; ++m) { bf16_t* rowp = base + (size_t)(row0 + ai * 128 + m * 16) * 1024;
#pragma unroll
                for (int bj = 0; bj < 2; ++bj) { pg8::f32x4 v0 = acc[ai][bj][m][0], v1 = acc[ai][bj][m][1];
                    if (isg) {
#pragma unroll
                        for (int j = 0; j < 4; ++j) { v0[j] = geluf_(v0[j]); v1[j] = geluf_(v1[j]); } }
                    u32x4 w; w.x = cvt_pk_bf16(v0[0], v0[1]); w.y = cvt_pk_bf16(v0[2], v0[3]); w.z = cvt_pk_bf16(v1[0], v1[1]); w.w = cvt_pk_bf16(v1[2], v1[3]);
                    *(u32x4*)(rowp + bj * 128) = w; } }
    }
};
template <class Epi> DI void run_gemm(unsigned char* shm, const bf16_t* A, const bf16_t* Bt, int N, int K, const Epi& E) {
    pg8::Gemm g; g.A = A; g.Bt = Bt; g.M = MT; g.N = N; g.K = K;
    pg8::StaticOrder S; S.init(MT, N, (int)gridDim.x, (int)bidx());
    pg8::gemm_phase<Epi, pg8::StaticOrder, false>((PG8_LAS unsigned char*)shm, g, S, E, nullptr);
    __syncthreads();
}

DI int srccol(int map, int j) {
    if (map == 0) return j;
    if (map == 1) { const int pn = j >> 8, c = j & 255; return c < 128 ? pn * 128 + c : DFF + pn * 128 + (c - 128); }
    if (j < 2560) return j;
    if (j < 5632) return j + 16;
    if (j < 5648) return 2560 + (j - 5632);
    if (j < 5656) return j;
    return -1;
}
DI void transpose_job(unsigned char* shm, const float* src, int ld, int K, int N, bf16_t* dst, int map, int rot) {
    float* tile = (float*)shm;
    const int tk = K >> 6, ntiles = (N >> 7) * tk, tid = tidx(), G = gridDim.x;
    const int start = (int)((bidx() + G - (rot % G)) % G);
    for (int t = start; t < ntiles; t += 2 * G) {
        const bool two = t + G < ntiles;
        f32x4 v[2][4];
#pragma unroll
        for (int u = 0; u < 2; ++u) { const int tt = t + u * G; if (u == 1 && !two) break;
            const int j0 = (tt / tk) << 7, k0 = (tt % tk) << 6;
#pragma unroll
            for (int i = 0; i < 4; ++i) { const int q = tid + i * NTHR, kk = q >> 5, j4 = (q & 31) * 4, sc = srccol(map, j0 + j4);
                v[u][i] = sc >= 0 ? __builtin_nontemporal_load((const f32x4*)(src + (size_t)(k0 + kk) * ld + sc)) : (f32x4){0.f, 0.f, 0.f, 0.f}; } }
#pragma unroll
        for (int u = 0; u < 2; ++u) { if (u == 1 && !two) break;
#pragma unroll
            for (int i = 0; i < 4; ++i) { const int q = tid + i * NTHR, kk = q >> 5, j4 = (q & 31) * 4;
#pragma unroll
                for (int cc = 0; cc < 4; ++cc) tile[u * (64 * 129) + kk * 129 + j4 + cc] = v[u][i][cc]; } }
        __syncthreads();
#pragma unroll
        for (int u = 0; u < 2; ++u) { const int tt = t + u * G; if (u == 1 && !two) break;
            const int j0 = (tt / tk) << 7, k0 = (tt % tk) << 6;
#pragma unroll
            for (int i = 0; i < 2; ++i) { const int q = tid + i * NTHR, kg = q & 7, jj = q >> 3;
                const float* tp = tile + u * (64 * 129) + (kg * 8) * 129 + jj;
                u32x4 o; o.x = cvt_pk_bf16(tp[0], tp[129]); o.y = cvt_pk_bf16(tp[2 * 129], tp[3 * 129]); o.z = cvt_pk_bf16(tp[4 * 129], tp[5 * 129]); o.w = cvt_pk_bf16(tp[6 * 129], tp[7 * 129]);
                *(u32x4*)(dst + (size_t)(j0 + jj) * K + k0 + kg * 8) = o; } }
        __syncthreads();
    }
}
DI void convert_weights(unsigned char* shm, const Params& p, int layer) {
    unsigned char* ws = p.ws; int rot = 0;
    for (int s = 0; s < 2; ++s) {
        transpose_job(shm, p.ffn_w_in + (size_t)(layer * 2 + s) * 1024 * 5632, 5632, 1024, 5632, (bf16_t*)(ws + OFF_WFIN + s * SZ_WFIN), 1, rot); rot += 44 * 16;
        transpose_job(shm, p.ffn_w_out + (size_t)(layer * 2 + s) * 2816 * 1024, 1024, 2816, 1024, (bf16_t*)(ws + OFF_WFOUT + s * SZ_WFOUT), 0, rot); rot += 8 * 44;
    }
    const int i = layer >> 1;
    if ((layer & 1) == 0) {
        transpose_job(shm, p.hyb_w_in + (size_t)i * 1024 * 5656, 5656, 1024, 5888, (bf16_t*)(ws + OFF_WMIN), 2, rot); rot += 46 * 16;
        transpose_job(shm, p.hyb_w_out + (size_t)i * 2048 * 1024, 1024, 2048, 1024, (bf16_t*)(ws + OFF_WMOUT), 0, rot);
    } else {
        transpose_job(shm, p.rec_w_in + (size_t)i * 1024 * 2048, 2048, 1024, 2048, (bf16_t*)(ws + OFF_WMIN), 0, rot); rot += 16 * 16;
        transpose_job(shm, p.rec_w_out + (size_t)i * 1024 * 1024, 1024, 1024, 1024, (bf16_t*)(ws + OFF_WMOUT), 0, rot); rot += 8 * 16;
        for (int nb = 0; nb < 8; ++nb) {
            transpose_job(shm, p.rec_w_a + ((size_t)i * 8 + nb) * 128 * 128, 128, 128, 128, (bf16_t*)(ws + OFF_WG) + (size_t)nb * 256 * 128, 0, rot); rot += 2;
            transpose_job(shm, p.rec_w_x + ((size_t)i * 8 + nb) * 128 * 128, 128, 128, 128, (bf16_t*)(ws + OFF_WG) + (size_t)nb * 256 * 128 + 128 * 128, 0, rot); rot += 2;
        }
    }
}

DI void resnorm_phase(const float* xin, const bf16_t* h, float w, const float* gpost, const float* gpre, float* xout, bf16_t* xn) {
    const int lane = tidx() & 63, gw = bidx() * 8 + (tidx() >> 6), nw = gridDim.x * 8;
    for (int r0 = gw; r0 < MT; r0 += 2 * nw) {
        f32x4 xv[2][4]; u32x2 hq[2][4];
#pragma unroll
        for (int u = 0; u < 2; ++u)
#pragma unroll
            for (int i = 0; i < 4; ++i) { const size_t o = (size_t)(r0 + u * nw) * DM + i * 256 + lane * 4;
                if (r0 + u * nw < MT) { xv[u][i] = __builtin_nontemporal_load((const f32x4*)(xin + o)); if (h) hq[u][i] = __builtin_nontemporal_load((const u32x2*)(h + o)); }
                else { xv[u][i] = (f32x4){0.f, 0.f, 0.f, 0.f}; hq[u][i] = (u32x2){0u, 0u}; } }
#pragma unroll
        for (int u = 0; u < 2; ++u) {
            const int r = r0 + u * nw; if (r >= MT) break;
            if (h) {
                float hv[4][4]; float ss = 0.f;
#pragma unroll
                for (int i = 0; i < 4; ++i) { const u32x2 q = hq[u][i];
                    hv[i][0] = bflo(q.x); hv[i][1] = bfhi(q.x); hv[i][2] = bflo(q.y); hv[i][3] = bfhi(q.y);
                    ss += hv[i][0] * hv[i][0] + hv[i][1] * hv[i][1] + hv[i][2] * hv[i][2] + hv[i][3] * hv[i][3]; }
#pragma unroll
                for (int o = 32; o > 0; o >>= 1) ss += __shfl_xor(ss, o);
                const float sc = w * rsqrtf(ss * (1.0f / DM) + EPS);
#pragma unroll
                for (int i = 0; i < 4; ++i) { const f32x4 g = *(const f32x4*)(gpost + i * 256 + lane * 4);
#pragma unroll
                    for (int j = 0; j < 4; ++j) xv[u][i][j] += sc * hv[i][j] * g[j]; }
            }
#pragma unroll
            for (int i = 0; i < 4; ++i) __builtin_nontemporal_store(xv[u][i], (f32x4*)(xout + (size_t)r * DM + i * 256 + lane * 4));
            if (gpre) {
                float ss = 0.f;
#pragma unroll
                for (int i = 0; i < 4; ++i) ss += xv[u][i][0] * xv[u][i][0] + xv[u][i][1] * xv[u][i][1] + xv[u][i][2] * xv[u][i][2] + xv[u][i][3] * xv[u][i][3];
#pragma unroll
                for (int o = 32; o > 0; o >>= 1) ss += __shfl_xor(ss, o);
                const float sc = rsqrtf(ss * (1.0f / DM) + EPS);
#pragma unroll
                for (int i = 0; i < 4; ++i) { const f32x4 g = *(const f32x4*)(gpre + i * 256 + lane * 4);
                    u32x2 q; q.x = cvt_pk_bf16(xv[u][i][0] * sc * g[0], xv[u][i][1] * sc * g[1]); q.y = cvt_pk_bf16(xv[u][i][2] * sc * g[2], xv[u][i][3] * sc * g[3]);
                    *(u32x2*)(xn + (size_t)r * DM + i * 256 + lane * 4) = q; }
            }
        }
    }
}
DI void hyb_prep_phase(unsigned char* shm, const Params& p, int li) {
    unsigned char* ws = p.ws; const int tid = tidx(), lane = tid & 63, wid = tid >> 6;
    const float* misc = (const float*)(ws + OFF_MISC);
    { float* cum = (float*)(ws + OFF_CUM); float* sw = (float*)shm;
      for (int it = bidx(); it < 64; it += gridDim.x) {
        const int b = it >> 3, h = it & 7; const float bf = p.fox_b_f[li * 8 + h];
        float v[8]; float run = 0.f;
#pragma unroll
        for (int j = 0; j < 8; ++j) { const float fr_ = misc[(size_t)(b * SEQ + tid * 8 + j) * 32 + 16 + h]; run += logsigf_(fr_ + bf); v[j] = run; }
        float inc = run;
#pragma unroll
        for (int o = 1; o < 64; o <<= 1) { const float t = __shfl_up(inc, o); if (lane >= o) inc += t; }
        if (lane == 63) sw[wid] = inc;
        __syncthreads();
        float base = inc - run;
        for (int w2 = 0; w2 < wid; ++w2) base += sw[w2];
#pragma unroll
        for (int j = 0; j < 8; ++j) cum[(size_t)it * SEQ + tid * 8 + j] = base + v[j];
        __syncthreads();
      } }
    { float* dtb = (float*)(ws + OFF_DT); float* acs = (float*)(ws + OFF_ACS); float* sA = (float*)shm;
      for (int it = bidx(); it < 256; it += gridDim.x) {
        const int tok0 = it * 128, l = tid >> 2, hq = (tid & 3) * 4;
        const f32x4 raw = *(const f32x4*)(misc + (size_t)(tok0 + l) * 32 + hq);
        f32x4 dtv;
#pragma unroll
        for (int j = 0; j < 4; ++j) { dtv[j] = softplusf_(raw[j] + p.ssm_dt_bias[li * 16 + hq + j]); sA[l * 16 + hq + j] = dtv[j] * (-__expf(p.ssm_a_log[li * 16 + hq + j])); }
        *(f32x4*)(dtb + (size_t)(tok0 + l) * 16 + hq) = dtv;
        __syncthreads();
        if (tid < 16) { float run = 0.f; for (int q = 0; q < 128; ++q) { run += sA[q * 16 + tid]; sA[q * 16 + tid] = run; } }
        __syncthreads();
        *(f32x4*)(acs + (size_t)(tok0 + l) * 16 + hq) = *(const f32x4*)(sA + l * 16 + hq);
        __syncthreads();
      } }
    { const bf16_t* src = (const bf16_t*)(ws + OFF_XBCP); bf16_t* dst = (bf16_t*)(ws + OFF_XN);
      const float* cw = p.ssm_conv_w + (size_t)li * 4 * 1536; const float* cb = p.ssm_conv_b + (size_t)li * 1536;
      const int total = (MT / 16) * 192;
      for (int idx = bidx() * NTHR + tid; idx < total; idx += gridDim.x * NTHR) {
        const int tb = idx / 192, c0 = (idx % 192) * 8, t0 = tb * 16, s0 = t0 & (SEQ - 1);
        float w[4][8], bias[8];
#pragma unroll
        for (int k = 0; k < 4; ++k) { const f32x4 a = *(const f32x4*)(cw + k * 1536 + c0), b2 = *(const f32x4*)(cw + k * 1536 + c0 + 4);
#pragma unroll
            for (int j = 0; j < 4; ++j) { w[k][j] = a[j]; w[k][4 + j] = b2[j]; } }
        { const f32x4 a = *(const f32x4*)(cb + c0), b2 = *(const f32x4*)(cb + c0 + 4);
#pragma unroll
          for (int j = 0; j < 4; ++j) { bias[j] = a[j]; bias[4 + j] = b2[j]; } }
        float h0[8], h1[8], h2[8];
#pragma unroll
        for (int j = 0; j < 8; ++j) { h0[j] = 0.f; h1[j] = 0.f; h2[j] = 0.f; }
        if (s0 > 0) {
            const u32x4 a = *(const u32x4*)(src + (size_t)(t0 - 3) * 1536 + c0), b2 = *(const u32x4*)(src + (size_t)(t0 - 2) * 1536 + c0), c2 = *(const u32x4*)(src + (size_t)(t0 - 1) * 1536 + c0);
#pragma unroll
            for (int j = 0; j < 4; ++j) { h0[2 * j] = bflo(a[j]); h0[2 * j + 1] = bfhi(a[j]); h1[2 * j] = bflo(b2[j]); h1[2 * j + 1] = bfhi(b2[j]); h2[2 * j] = bflo(c2[j]); h2[2 * j + 1] = bfhi(c2[j]); }
        }
        u32x4 rw[16];
#pragma unroll
        for (int q = 0; q < 16; ++q) rw[q] = __builtin_nontemporal_load((const u32x4*)(src + (size_t)(t0 + q) * 1536 + c0));
#pragma unroll
        for (int q = 0; q < 16; ++q) {
            const u32x4 a = rw[q];
            float cur[8], y[8];
#pragma unroll
            for (int j = 0; j < 4; ++j) { cur[2 * j] = bflo(a[j]); cur[2 * j + 1] = bfhi(a[j]); }
#pragma unroll
            for (int j = 0; j < 8; ++j) { y[j] = siluf_(bias[j] + w[0][j] * h0[j] + w[1][j] * h1[j] + w[2][j] * h2[j] + w[3][j] * cur[j]); h0[j] = h1[j]; h1[j] = h2[j]; h2[j] = cur[j]; }
            u32x4 o; o.x = cvt_pk_bf16(y[0], y[1]); o.y = cvt_pk_bf16(y[2], y[3]); o.z = cvt_pk_bf16(y[4], y[5]); o.w = cvt_pk_bf16(y[6], y[7]);
            *(u32x4*)(dst + (size_t)(t0 + q) * 1536 + c0) = o;
        }
      } }
}

constexpr int LDT = 136;
constexpr int RSX = 144;
typedef short s16x4 __attribute__((ext_vector_type(4)));
DI unsigned tr_lane_off(int lane, int rs) { return (unsigned)((8 * (lane >> 4) + ((lane >> 2) & 3)) * rs + (lane & 3) * 8); }
DI bf16x8 tr_frag(unsigned a, unsigned rs4) {
    s16x4 lo, hi;
    asm volatile("ds_read_b64_tr_b16 %0, %2\n\tds_read_b64_tr_b16 %1, %3\n\ts_waitcnt lgkmcnt(0)" : "=&v"(lo), "=&v"(hi) : "v"(a), "v"(a + rs4) : "memory");
    return (bf16x8){lo[0], lo[1], lo[2], lo[3], hi[0], hi[1], hi[2], hi[3]};
}
DI void tr_frag4(unsigned a, unsigned rs4, bf16x8 (&f)[4]) {
    s16x4 l0, h0, l1, h1, l2, h2, l3, h3; const unsigned b = a + rs4;
    asm volatile("ds_read_b64_tr_b16 %0, %8\n\tds_read_b64_tr_b16 %1, %9\n\tds_read_b64_tr_b16 %2, %8 offset:32\n\tds_read_b64_tr_b16 %3, %9 offset:32\n\t"
                 "ds_read_b64_tr_b16 %4, %8 offset:64\n\tds_read_b64_tr_b16 %5, %9 offset:64\n\tds_read_b64_tr_b16 %6, %8 offset:96\n\tds_read_b64_tr_b16 %7, %9 offset:96\n\ts_waitcnt lgkmcnt(0)"
                 : "=&v"(l0), "=&v"(h0), "=&v"(l1), "=&v"(h1), "=&v"(l2), "=&v"(h2), "=&v"(l3), "=&v"(h3) : "v"(a), "v"(b) : "memory");
    f[0] = (bf16x8){l0[0], l0[1], l0[2], l0[3], h0[0], h0[1], h0[2], h0[3]}; f[1] = (bf16x8){l1[0], l1[1], l1[2], l1[3], h1[0], h1[1], h1[2], h1[3]};
    f[2] = (bf16x8){l2[0], l2[1], l2[2], l2[3], h2[0], h2[1], h2[2], h2[3]}; f[3] = (bf16x8){l3[0], l3[1], l3[2], l3[3], h3[0], h3[1], h3[2], h3[3]};
}
DI void ssd_states_phase(unsigned char* shm, const Params& p) {
    unsigned char* ws = p.ws; const int tid = tidx(), lane = tid & 63, w = __builtin_amdgcn_readfirstlane(tid >> 6), fr = lane & 15, fq = lane >> 4;
    const bf16_t* xbc = (const bf16_t*)(ws + OFF_XN); const float* dtb = (const float*)(ws + OFF_DT); const float* acs = (const float*)(ws + OFF_ACS);
    bf16_t* st = (bf16_t*)(ws + OFF_ST);
    bf16_t* Bs = (bf16_t*)shm;
    unsigned char* Xs = shm + 128 * LDT * 2;
    const unsigned bsa = (unsigned)(uintptr_t)Bs + tr_lane_off(lane, LDT * 2) + (16 * w) * 2;
    const unsigned xsa = (unsigned)(uintptr_t)Xs + tr_lane_off(lane, RSX);
    for (int it = bidx(); it < 512; it += gridDim.x) {
        const int g = it & 1, bc = it >> 1, tok0 = bc * 128;
        __syncthreads();
#pragma unroll
        for (int i = 0; i < 4; ++i) { const int v = tid + i * NTHR, l = v >> 4, n8 = (v & 15) * 8;
            *(u32x4*)(Bs + l * LDT + n8) = *(const u32x4*)(xbc + (size_t)(tok0 + l) * 1536 + 1024 + g * 128 + n8); }
        for (int k = 0; k < 8; ++k) {
            const int hh = g * 8 + k; const float aend = acs[(size_t)(tok0 + 127) * 16 + hh];
            __syncthreads();
#pragma unroll
            for (int i = 0; i < 2; ++i) { const int v = tid + i * NTHR, l = v >> 3, p8 = (v & 7) * 8;
                const float wl = __expf(aend - acs[(size_t)(tok0 + l) * 16 + hh]) * dtb[(size_t)(tok0 + l) * 16 + hh];
                const u32x4 q = *(const u32x4*)(xbc + (size_t)(tok0 + l) * 1536 + hh * 64 + p8); u32x4 o;
#pragma unroll
                for (int j = 0; j < 4; ++j) o[j] = cvt_pk_bf16(bflo(q[j]) * wl, bfhi(q[j]) * wl);
                *(u32x4*)(Xs + l * RSX + p8 * 2) = o; }
            __syncthreads();
            f32x4 acc[4];
#pragma unroll
            for (int j = 0; j < 4; ++j) acc[j] = (f32x4){0.f, 0.f, 0.f, 0.f};
#pragma unroll
            for (int ks = 0; ks < 4; ++ks) { const bf16x8 a = tr_frag(bsa + 32 * ks * (LDT * 2), 4 * LDT * 2);
                bf16x8 b[4]; tr_frag4(xsa + 32 * ks * RSX, 4 * RSX, b);
#pragma unroll
                for (int j = 0; j < 4; ++j) acc[j] = MFMA16(a, b[j], acc[j]); }
            bf16_t* sp = st + ((size_t)bc * 16 + hh) * 8192;
#pragma unroll
            for (int j = 0; j < 4; ++j) { u32x2 o; o.x = cvt_pk_bf16(acc[j][0], acc[j][1]); o.y = cvt_pk_bf16(acc[j][2], acc[j][3]);
                *(u32x2*)(sp + (16 * j + fr) * 128 + 16 * w + 4 * fq) = o; }
        }
    }
    __syncthreads();
}
DI void ssd_carry_phase(const Params& p) {
    unsigned char* ws = p.ws; const float* acs = (const float*)(ws + OFF_ACS); bf16_t* st = (bf16_t*)(ws + OFF_ST);
    for (int idx = bidx() * NTHR + tidx(); idx < 128 * 1024; idx += gridDim.x * NTHR) {
        const int bh = idx >> 10, e8 = (idx & 1023) * 8, b = bh >> 4, h = bh & 15;
        float carry[8];
#pragma unroll
        for (int j = 0; j < 8; ++j) carry[j] = 0.f;
        for (int z0 = 0; z0 < 32; z0 += 16) {
            u32x4 q[16]; float dec[16];
#pragma unroll
            for (int zz = 0; zz < 16; ++zz) { const int z = z0 + zz; q[zz] = *(const u32x4*)(st + ((size_t)(b * 32 + z) * 16 + h) * 8192 + e8);
                dec[zz] = __expf(acs[(size_t)(b * SEQ + z * 128 + 127) * 16 + h]); }
#pragma unroll
            for (int zz = 0; zz < 16; ++zz) { const int z = z0 + zz;
                u32x4 o; o.x = cvt_pk_bf16(carry[0], carry[1]); o.y = cvt_pk_bf16(carry[2], carry[3]); o.z = cvt_pk_bf16(carry[4], carry[5]); o.w = cvt_pk_bf16(carry[6], carry[7]);
                *(u32x4*)(st + ((size_t)(b * 32 + z) * 16 + h) * 8192 + e8) = o;
#pragma unroll
                for (int j = 0; j < 4; ++j) { carry[2 * j] = carry[2 * j] * dec[zz] + bflo(q[zz][j]); carry[2 * j + 1] = carry[2 * j + 1] * dec[zz] + bfhi(q[zz][j]); } }
        }
    }
}

DI void ssd_out_phase(unsigned char* shm, const Params& p, int li) {
    unsigned char* ws = p.ws; const int tid = tidx(), lane = tid & 63, w = __builtin_amdgcn_readfirstlane(tid >> 6), fr = lane & 15, fq = lane >> 4;
    const bf16_t* xbc = (const bf16_t*)(ws + OFF_XN); const float* dtb = (const float*)(ws + OFF_DT); const float* acs = (const float*)(ws + OFF_ACS);
    const bf16_t* st = (const bf16_t*)(ws + OFF_ST); bf16_t* ycat = (bf16_t*)(ws + OFF_YCAT);
    constexpr int HB = 128 * RSX + 64 * LDT * 2;
    bf16_t* Cs = (bf16_t*)shm; bf16_t* Bs = Cs + 128 * LDT;
    bf16_t* Ml = (bf16_t*)(shm + 2 * HB);
    float* hv = (float*)(shm + 2 * HB + 128 * LDT * 2);
    float* ssq = hv + 512;
    const int tl = 16 * w + fr;
    const int sl0 = tid >> 3, sp8 = (tid & 7) * 8;
    const int tp0 = tid >> 4, tn8 = (tid & 15) * 8;
    for (int it = bidx(); it < 512; it += gridDim.x) {
        const int g = it & 1, bc = it >> 1, tok0 = bc * 128;
        __syncthreads();
#pragma unroll
        for (int i = 0; i < 4; ++i) { const int v = tid + i * NTHR, l = v >> 4, n8 = (v & 15) * 8;
            *(u32x4*)(Bs + l * LDT + n8) = *(const u32x4*)(xbc + (size_t)(tok0 + l) * 1536 + 1024 + g * 128 + n8);
            *(u32x4*)(Cs + l * LDT + n8) = *(const u32x4*)(xbc + (size_t)(tok0 + l) * 1536 + 1280 + g * 128 + n8); }
        if (tid < 128) ssq[tid] = 0.f;
        u32x4 xq[2], sq[2]; float dq[2], hq = 0.f;
#define SSD_FETCH(hh_) do { const int hh__ = (hh_);                                                                                          \
            _Pragma("unroll") for (int i = 0; i < 2; ++i) { xq[i] = *(const u32x4*)(xbc + (size_t)(tok0 + sl0 + 64 * i) * 1536 + hh__ * 64 + sp8);   \
                dq[i] = dtb[(size_t)(tok0 + sl0 + 64 * i) * 16 + hh__];                                                                        \
                sq[i] = *(const u32x4*)(st + ((size_t)bc * 16 + hh__) * 8192 + (tp0 + 32 * i) * 128 + tn8); }                                  \
            if (tid < 256) hq = (tid < 128 ? acs : dtb)[(size_t)(tok0 + (tid & 127)) * 16 + hh__]; } while (0)
#define SSD_STORE(buf_) do { unsigned char* hb_ = shm + (buf_) * HB;                                                                          \
            _Pragma("unroll") for (int i = 0; i < 2; ++i) { u32x4 o_;                                                                        \
                _Pragma("unroll") for (int j = 0; j < 4; ++j) o_[j] = cvt_pk_bf16(bflo(xq[i][j]) * dq[i], bfhi(xq[i][j]) * dq[i]);            \
                *(u32x4*)(hb_ + (sl0 + 64 * i) * RSX + sp8 * 2) = o_;                                                                         \
                *(u32x4*)((bf16_t*)(hb_ + 128 * RSX) + (tp0 + 32 * i) * LDT + tn8) = sq[i]; }                                                 \
            if (tid < 256) hv[(buf_) * 256 + tid] = hq; } while (0)
        SSD_FETCH(g * 8);
        __syncthreads();
        bf16x8 Cf[4];
#pragma unroll
        for (int ks = 0; ks < 4; ++ks) Cf[ks] = *(const bf16x8*)(Cs + tl * LDT + 32 * ks + 8 * fq);
        f32x4 G[8];
#pragma unroll
        for (int j = 0; j < 8; ++j) { G[j] = (f32x4){0.f, 0.f, 0.f, 0.f};
            if (j <= w) {
#pragma unroll
                for (int ks = 0; ks < 4; ++ks) { const bf16x8 a = *(const bf16x8*)(Bs + (16 * j + fr) * LDT + 32 * ks + 8 * fq); G[j] = MFMA16(a, Cf[ks], G[j]); } } }
        __syncthreads();
        SSD_STORE(0);
        __syncthreads();
        for (int k = 0; k < 8; ++k) {
            const int hh = g * 8 + k, cur = k & 1; const float Dh = p.ssm_d[li * 16 + hh];
            if (k < 7) SSD_FETCH(hh + 1);
            u32x2 zq[4];
#pragma unroll
            for (int j = 0; j < 4; ++j) zq[j] = *(const u32x2*)(ycat + (size_t)(tok0 + tl) * 2048 + hh * 64 + 16 * j + 4 * fq);
            const unsigned char* hb = shm + cur * HB; const bf16_t* St = (const bf16_t*)(hb + 128 * RSX);
            const float* acs_s = hv + cur * 256; const float* dt_s = acs_s + 128;
            const unsigned xsa = (unsigned)(uintptr_t)hb + tr_lane_off(lane, RSX);
            const float al = acs_s[tl], dsk = Dh * __builtin_amdgcn_rcpf(dt_s[tl]);
#pragma unroll
            for (int j = 0; j < 8; ++j) {
                if (j <= (w | 1)) { const int s0 = 16 * j + 4 * fq; float m[4] = {0.f, 0.f, 0.f, 0.f};
                    if (j <= w) { const f32x4 as_ = *(const f32x4*)(acs_s + s0);
#pragma unroll
                        for (int i = 0; i < 4; ++i) m[i] = G[j][i] * __expf(fminf(al - as_[i], 0.f));
                        if (j == w) {
#pragma unroll
                            for (int i = 0; i < 4; ++i) { const int dd = fr - 4 * fq - i; m[i] = dd >= 0 ? m[i] : 0.f; if (dd == 0) m[i] += dsk; } } }
                    u32x2 o; o.x = cvt_pk_bf16(m[0], m[1]); o.y = cvt_pk_bf16(m[2], m[3]); *(u32x2*)(Ml + tl * LDT + s0) = o; } }
            f32x4 yd[4], yo[4];
#pragma unroll
            for (int j = 0; j < 4; ++j) { yd[j] = (f32x4){0.f, 0.f, 0.f, 0.f}; yo[j] = (f32x4){0.f, 0.f, 0.f, 0.f}; }
#pragma unroll
            for (int ks = 0; ks < 4; ++ks) {
                if (ks <= (w >> 1)) { const bf16x8 b = *(const bf16x8*)(Ml + tl * LDT + 32 * ks + 8 * fq);
#pragma unroll
                    for (int j = 0; j < 4; ++j) { const bf16x8 a = tr_frag(xsa + 32 * ks * RSX + 16 * j * 2, 4 * RSX); yd[j] = MFMA16(a, b, yd[j]); } } }
#pragma unroll
            for (int ks = 0; ks < 4; ++ks)
#pragma unroll
                for (int j = 0; j < 4; ++j) { const bf16x8 a = *(const bf16x8*)(St + (16 * j + fr) * LDT + 32 * ks + 8 * fq); yo[j] = MFMA16(a, Cf[ks], yo[j]); }
            const float ea = __expf(al); float part = 0.f;
#pragma unroll
            for (int j = 0; j < 4; ++j) { const float zv[4] = {bflo(zq[j].x), bfhi(zq[j].x), bflo(zq[j].y), bfhi(zq[j].y)}; float y[4];
#pragma unroll
                for (int i = 0; i < 4; ++i) { y[i] = (yd[j][i] + ea * yo[j][i]) * siluf_(zv[i]); part += y[i] * y[i]; }
                u32x2 o; o.x = cvt_pk_bf16(y[0], y[1]); o.y = cvt_pk_bf16(y[2], y[3]); *(u32x2*)(ycat + (size_t)(tok0 + tl) * 2048 + hh * 64 + 16 * j + 4 * fq) = o; }
            part += __shfl_xor(part, 16); part += __shfl_xor(part, 32);
            if (fq == 0) ssq[tl] += part;
            if (k < 7) SSD_STORE(cur ^ 1);
            __syncthreads();
        }
#undef SSD_FETCH
#undef SSD_STORE
        asm volatile("s_waitcnt vmcnt(0)" ::: "memory"); __syncthreads();
        { const f32x4 g0 = *(const f32x4*)(p.ssm_norm_g + li * 1024 + g * 512 + lane * 8), g1 = *(const f32x4*)(p.ssm_norm_g + li * 1024 + g * 512 + lane * 8 + 4);
          for (int rr = 0; rr < 16; ++rr) { const int l = 16 * w + rr; const float sc = rsqrtf(ssq[l] * (1.0f / 512.0f) + EPS);
            bf16_t* yp = ycat + (size_t)(tok0 + l) * 2048 + g * 512 + lane * 8;
            const u32x4 q = *(const u32x4*)yp; u32x4 o;
            o.x = cvt_pk_bf16(bflo(q.x) * sc * g0[0], bfhi(q.x) * sc * g0[1]); o.y = cvt_pk_bf16(bflo(q.y) * sc * g0[2], bfhi(q.y) * sc * g0[3]);
            o.z = cvt_pk_bf16(bflo(q.z) * sc * g1[0], bfhi(q.z) * sc * g1[1]); o.w = cvt_pk_bf16(bflo(q.w) * sc * g1[2], bfhi(q.w) * sc * g1[3]);
            *(u32x4*)yp = o; } }
    }
    __syncthreads();
}

DI void attn_phase(unsigned char* shm, const Params& p) {
    using bf = fa::bf16; char* lds = (char*)shm; float* ckl = (float*)(lds + fa::LDS_BYTES);
    unsigned char* ws = p.ws; const bf* Q = (const bf*)(ws + OFF_QKV); const bf* K = Q + (size_t)MT * 1024; const bf* V = K + (size_t)MT * 1024;
    bf* Y = (bf*)(ws + OFF_YCAT); const float* cum = (const float*)(ws + OFF_CUM);
    const int total = 512, stride = gridDim.x; int L = bidx(); if (L >= total) return;
    auto mkref = [&](int L_, int pass) { const int k_ = L_ >> 3, bh = (k_ >> 3) * 8 + (L_ & 7), x = k_ & 7, qb = pass ? 15 - x : x, b = bh >> 3, h = bh & 7;
        fa::BlockRef<bf, bf> r; r.Q = Q + ((size_t)bh * SEQ + (size_t)qb * 256) * 128; r.K = K + (size_t)bh * SEQ * 128; r.V = V + (size_t)bh * SEQ * 128;
        r.O = Y + ((size_t)(b * SEQ + qb * 256)) * 2048 + 1024 + h * 128; r.P0 = qb * 256; return r; };
    int pass = 0; fa::BlockRef<bf, bf> cur = mkref(L, 0);
    { const float* c = cum + (size_t)(((L >> 6) << 3) + (L & 7)) * SEQ; for (int i = tidx(); i < cur.P0 + 256; i += NTHR) ckl[i] = -c[i] * fa::BSC; }
    __syncthreads();
    fa::Seam<bf> S;
    fa::causal_swa_prime<bf, bf>(cur, fa::WINDOW, lds, S);
    for (;;) {
        const bool more_pass = pass == 0, more_item = L + stride < total, last = !more_pass && !more_item;
        int passn = pass + 1, Ln = L; if (!more_pass) { passn = 0; Ln = more_item ? L + stride : L; }
        const fa::BlockRef<bf, bf> nxt = last ? cur : mkref(Ln, passn);
        fa::causal_swa_block<bf, bf>(cur, nxt, fa::SKV, fa::WINDOW, lds, S, ckl);
        if (last) break;
        cur = nxt; pass = passn; L = Ln;
        { const float* c = cum + (size_t)(((L >> 6) << 3) + (L & 7)) * SEQ; for (int i = tidx(); i < cur.P0 + 256; i += NTHR) ckl[i] = -c[i] * fa::BSC; }
        __syncthreads();
    }
    asm volatile("s_waitcnt vmcnt(0)" ::: "memory");
    __syncthreads();
}
constexpr int LDF = 132;
DI float rcpf_(float x) { return __builtin_amdgcn_rcpf(x); }
DI float fsig_(float x) { return rcpf_(1.0f + __expf(-x)); }
DI void rec_scan_phase(unsigned char* shm, const Params& p, int ri) {
    unsigned char* ws = p.ws; const int tid = tidx(), lane = tid & 63, w = __builtin_amdgcn_readfirstlane(tid >> 6), fr = lane & 15, fq = lane >> 4;
    const bf16_t* xr = (const bf16_t*)(ws + OFF_YCAT) + (size_t)MT * 1024; const bf16_t* Wg = (const bf16_t*)(ws + OFF_WG);
    bf16_t* HL = (bf16_t*)(ws + OFF_QKV); bf16_t* PP = HL + (size_t)MT * 1024;
    float* RH = (float*)(ws + OFF_RH); float* RA = (float*)(ws + OFF_RA);
    bf16_t* Xa = (bf16_t*)shm;
    float* Xf = (float*)(shm + 64 * LDT * 2);
    float* La = Xf + 64 * LDF; float* Ua = La + 64 * LDF;
    const float* cw = p.rec_conv_w + (size_t)ri * 4 * 1024; const float* cb = p.rec_conv_b + (size_t)ri * 1024;
    const int c8 = (tid & 15) * 8, l0 = (tid >> 4) * 2;
    int nb_cur = -1;
    float wv[4][8], bias[8]; bf16x8 Wa[4], Wx[4]; f32x4 ba4, bx4, ls4;
#pragma unroll
    for (int k = 0; k < 4; ++k) {
#pragma unroll
        for (int j = 0; j < 8; ++j) wv[k][j] = 0.f; Wa[k] = (bf16x8){0, 0, 0, 0, 0, 0, 0, 0}; Wx[k] = Wa[k]; }
#pragma unroll
    for (int j = 0; j < 8; ++j) bias[j] = 0.f;
    ba4 = (f32x4){0.f, 0.f, 0.f, 0.f}; bx4 = ba4; ls4 = ba4;
    u32x4 rows[5];
#define REC_FETCH(it_) do { const int nb_ = (it_) & 7, t0_ = ((it_) >> 3) * 64 + l0, s0_ = t0_ & (SEQ - 1);                    \
        _Pragma("unroll") for (int q = 0; q < 5; ++q) { rows[q] = (u32x4){0u, 0u, 0u, 0u};                                       \
            if (s0_ - 3 + q >= 0) rows[q] = *(const u32x4*)(xr + (size_t)(t0_ - 3 + q) * 1024 + nb_ * 128 + c8); } } while (0)
    int it = bidx();
    if (it < 4096) REC_FETCH(it);
    for (; it < 4096; it += gridDim.x) {
        const int nb = it & 7, chunk = it >> 3, tok0 = chunk * 64, ch0 = nb * 128;
        if (nb != nb_cur) {
            nb_cur = nb; const int c = ch0 + c8;
#pragma unroll
            for (int k = 0; k < 4; ++k) { const f32x4 a = *(const f32x4*)(cw + k * 1024 + c), b2 = *(const f32x4*)(cw + k * 1024 + c + 4);
#pragma unroll
                for (int j = 0; j < 4; ++j) { wv[k][j] = a[j]; wv[k][4 + j] = b2[j]; } }
            { const f32x4 a = *(const f32x4*)(cb + c), b2 = *(const f32x4*)(cb + c + 4);
#pragma unroll
              for (int j = 0; j < 4; ++j) { bias[j] = a[j]; bias[4 + j] = b2[j]; } }
            const bf16_t* Wb = Wg + (size_t)nb * 256 * 128;
#pragma unroll
            for (int ks = 0; ks < 4; ++ks) { Wa[ks] = *(const bf16x8*)(Wb + (16 * w + fr) * 128 + 32 * ks + 8 * fq); Wx[ks] = *(const bf16x8*)(Wb + (128 + 16 * w + fr) * 128 + 32 * ks + 8 * fq); }
            const int ch = ch0 + 16 * w + 4 * fq;
            ba4 = *(const f32x4*)(p.rec_b_a + ri * 1024 + ch); bx4 = *(const f32x4*)(p.rec_b_x + ri * 1024 + ch);
            const f32x4 lm = *(const f32x4*)(p.rec_lambda + ri * 1024 + ch);
#pragma unroll
            for (int i = 0; i < 4; ++i) ls4[i] = 8.0f * logsigf_(lm[i]);
        }
        __syncthreads();
#pragma unroll
        for (int q = 0; q < 2; ++q) { float y[8];
#pragma unroll
            for (int j = 0; j < 8; ++j) { const int jj = j >> 1;
                const float r0 = (j & 1) ? bfhi(rows[q][jj]) : bflo(rows[q][jj]), r1 = (j & 1) ? bfhi(rows[q + 1][jj]) : bflo(rows[q + 1][jj]);
                const float r2 = (j & 1) ? bfhi(rows[q + 2][jj]) : bflo(rows[q + 2][jj]), r3 = (j & 1) ? bfhi(rows[q + 3][jj]) : bflo(rows[q + 3][jj]);
                y[j] = bias[j] + wv[0][j] * r0 + wv[1][j] * r1 + wv[2][j] * r2 + wv[3][j] * r3; }
            u32x4 o; o.x = cvt_pk_bf16(y[0], y[1]); o.y = cvt_pk_bf16(y[2], y[3]); o.z = cvt_pk_bf16(y[4], y[5]); o.w = cvt_pk_bf16(y[6], y[7]);
            *(u32x4*)(Xa + (l0 + q) * LDT + c8) = o;
            *(f32x4*)(Xf + (l0 + q) * LDF + c8) = (f32x4){y[0], y[1], y[2], y[3]}; *(f32x4*)(Xf + (l0 + q) * LDF + c8 + 4) = (f32x4){y[4], y[5], y[6], y[7]}; }
        __syncthreads();
        if (it + (int)gridDim.x < 4096) REC_FETCH(it + (int)gridDim.x);
        const int cc0 = 16 * w + 4 * fq;
#pragma unroll
        for (int tt = 0; tt < 4; ++tt) { const int tl = 16 * tt + fr;
            f32x4 ar = (f32x4){0.f, 0.f, 0.f, 0.f}, ax = (f32x4){0.f, 0.f, 0.f, 0.f};
#pragma unroll
            for (int ks = 0; ks < 4; ++ks) { const bf16x8 xf_ = *(const bf16x8*)(Xa + tl * LDT + 32 * ks + 8 * fq); ar = MFMA16(Wa[ks], xf_, ar); ax = MFMA16(Wx[ks], xf_, ax); }
            const f32x4 xv = *(const f32x4*)(Xf + tl * LDF + cc0);
            f32x4 lg4, u4;
#pragma unroll
            for (int i = 0; i < 4; ++i) {
                const float r = fsig_(ar[i] + ba4[i]), ig = fsig_(ax[i] + bx4[i]), lg = ls4[i] * r;
                const float z = 2.0f * lg;
                const float om = z < -0.3f ? 1.0f - __expf(z) : -z * (1.0f + z * (0.5f + z * (0.16666667f + z * (0.041666668f + z * (0.0083333333f + z * 0.0013888889f)))));
                lg4[i] = lg; u4[i] = __builtin_amdgcn_sqrtf(fmaxf(om, 0.f)) * (ig * xv[i]); }
            *(f32x4*)(La + tl * LDF + cc0) = lg4; *(f32x4*)(Ua + tl * LDF + cc0) = u4; }
        { const int c = lane & 15, q = lane >> 4, cc = 16 * w + c;
          float h = 0.f, A = 0.f;
#pragma unroll
          for (int t = 0; t < 16; ++t) { const int o = (16 * q + t) * LDF + cc; const float lgv = La[o]; A += lgv; h = __expf(lgv) * h + Ua[o]; La[o] = A; Ua[o] = h; }
          float cin = 0.f, Ain = 0.f;
#pragma unroll
          for (int qq = 0; qq < 3; ++qq) { const float aq = __shfl(A, c + 16 * qq), hq_ = __shfl(h, c + 16 * qq); if (qq < q) { cin = __expf(aq) * cin + hq_; Ain += aq; } }
          float hl = 0.f, At = 0.f;
#pragma unroll
          for (int t = 0; t < 16; ++t) { const int o = (16 * q + t) * LDF + cc; At = La[o]; hl = Ua[o] + __expf(At) * cin; Ua[o] = hl; La[o] = __expf(At + Ain); }
          if (q == 3) { RH[(size_t)chunk * 1024 + ch0 + cc] = hl; RA[(size_t)chunk * 1024 + ch0 + cc] = At + Ain; } }
        { const int t = lane; const size_t o = (size_t)(tok0 + t) * 1024 + ch0 + 16 * w;
          u32x4 oh[2], op[2];
#pragma unroll
          for (int k = 0; k < 2; ++k) { const f32x4 h0 = *(const f32x4*)(Ua + t * LDF + 16 * w + 8 * k), h1 = *(const f32x4*)(Ua + t * LDF + 16 * w + 8 * k + 4);
              const f32x4 p0 = *(const f32x4*)(La + t * LDF + 16 * w + 8 * k), p1 = *(const f32x4*)(La + t * LDF + 16 * w + 8 * k + 4);
              oh[k].x = cvt_pk_bf16(h0[0], h0[1]); oh[k].y = cvt_pk_bf16(h0[2], h0[3]); oh[k].z = cvt_pk_bf16(h1[0], h1[1]); oh[k].w = cvt_pk_bf16(h1[2], h1[3]);
              op[k].x = cvt_pk_bf16(p0[0], p0[1]); op[k].y = cvt_pk_bf16(p0[2], p0[3]); op[k].z = cvt_pk_bf16(p1[0], p1[1]); op[k].w = cvt_pk_bf16(p1[2], p1[3]); }
          *(u32x4*)(HL + o) = oh[0]; *(u32x4*)(HL + o + 8) = oh[1]; *(u32x4*)(PP + o) = op[0]; *(u32x4*)(PP + o + 8) = op[1]; }
    }
#undef REC_FETCH
    __syncthreads();
}
DI void rec_carry_phase(const Params& p) {
    unsigned char* ws = p.ws; const float* RH = (const float*)(ws + OFF_RH); const float* RA = (const float*)(ws + OFF_RA); float* RC = (float*)(ws + OFF_RC);
    for (int idx = bidx() * NTHR + tidx(); idx < 8192; idx += gridDim.x * NTHR) {
        const int b = idx >> 10, c = idx & 1023; float carry = 0.f;
        for (int z0 = 0; z0 < 64; z0 += 16) { float a[16], h[16];
#pragma unroll
            for (int z = 0; z < 16; ++z) { const size_t o = (size_t)(b * 64 + z0 + z) * 1024 + c; a[z] = RA[o]; h[z] = RH[o]; }
#pragma unroll
            for (int z = 0; z < 16; ++z) { RC[(size_t)(b * 64 + z0 + z) * 1024 + c] = carry; carry = __expf(a[z]) * carry + h[z]; } }
    }
}
DI void rec_final_phase(const Params& p) {
    unsigned char* ws = p.ws; const bf16_t* HL = (const bf16_t*)(ws + OFF_QKV); const bf16_t* PP = HL + (size_t)MT * 1024;
    const float* RC = (const float*)(ws + OFF_RC); bf16_t* gate = (bf16_t*)(ws + OFF_YCAT);
#pragma unroll 2
    for (int idx = bidx() * NTHR + tidx(); idx < MT * 128; idx += gridDim.x * NTHR) {
        const int t = idx >> 7, c8 = (idx & 127) * 8; const size_t o = (size_t)t * 1024 + c8;
        const u32x4 hq = __builtin_nontemporal_load((const u32x4*)(HL + o)), pq = __builtin_nontemporal_load((const u32x4*)(PP + o)), gq = __builtin_nontemporal_load((const u32x4*)(gate + o));
        const f32x4 c0 = *(const f32x4*)(RC + (size_t)(t >> 6) * 1024 + c8), c1 = *(const f32x4*)(RC + (size_t)(t >> 6) * 1024 + c8 + 4);
        u32x4 r;
        r.x = cvt_pk_bf16((bflo(hq.x) + bflo(pq.x) * c0[0]) * bflo(gq.x), (bfhi(hq.x) + bfhi(pq.x) * c0[1]) * bfhi(gq.x));
        r.y = cvt_pk_bf16((bflo(hq.y) + bflo(pq.y) * c0[2]) * bflo(gq.y), (bfhi(hq.y) + bfhi(pq.y) * c0[3]) * bfhi(gq.y));
        r.z = cvt_pk_bf16((bflo(hq.z) + bflo(pq.z) * c1[0]) * bflo(gq.z), (bfhi(hq.z) + bfhi(pq.z) * c1[1]) * bfhi(gq.z));
        r.w = cvt_pk_bf16((bflo(hq.w) + bflo(pq.w) * c1[2]) * bflo(gq.w), (bfhi(hq.w) + bfhi(pq.w) * c1[3]) * bfhi(gq.w));
        *(u32x4*)(gate + o) = r;
    }
}
constexpr int STEPS = 13, NPHASE = 1 + 4 * STEPS;
DI void ffn_resnorm(const Params& p, int layer, int gi_post, float wgt, const float* gpre, int probe) {
    unsigned char* ws = p.ws;
    float* xo = probe ? (float*)(ws + OFF_QKV) : p.out; bf16_t* xn = probe ? (bf16_t*)(ws + OFF_QKV + (size_t)MT * 1024 * 4) : (bf16_t*)(ws + OFF_XN);
    resnorm_phase(p.out, (const bf16_t*)(ws + OFF_XBCP), wgt, p.norm_g + ((size_t)layer * 6 + gi_post) * DM, gpre, xo, xn);
}
#define LAUNDER(x) asm volatile("" : "+s"(x))
DI void run_phase(unsigned char* shm, const Params& pin, int ph, int probe) {
    Params p = pin;
    size_t z_ = 0; asm volatile("" : "+s"(z_));
    p.x += z_; p.norm_g += z_; p.ffn_w_in += z_; p.ffn_w_out += z_; p.hyb_w_in += z_; p.ssm_conv_w += z_; p.ssm_conv_b += z_;
    p.ssm_dt_bias += z_; p.ssm_a_log += z_; p.ssm_d += z_; p.ssm_norm_g += z_; p.fox_b_f += z_; p.hyb_w_out += z_;
    p.rec_w_in += z_; p.rec_conv_w += z_; p.rec_conv_b += z_; p.rec_w_a += z_; p.rec_b_a += z_; p.rec_w_x += z_; p.rec_b_x += z_;
    p.rec_lambda += z_; p.rec_w_out += z_; p.out += z_; p.ws += z_;
    unsigned char* ws = p.ws;
    if (ph == 0) { convert_weights(shm, p, 0); resnorm_phase(p.x, nullptr, 0.f, nullptr, p.norm_g, p.out, (bf16_t*)(ws + OFF_XN)); return; }
    const int layer = (ph - 1) / STEPS, st = (ph - 1) % STEPS, hyb = (layer & 1) == 0, mi = layer >> 1;
    const float* ng = p.norm_g + (size_t)layer * 6 * DM;
    switch (st) {
    case 0: case 10: { EpiSwiglu E; E.O = (bf16_t*)(ws + OFF_QKV);
        run_gemm(shm, (const bf16_t*)(ws + OFF_XN), (const bf16_t*)(ws + OFF_WFIN + (st ? SZ_WFIN : 0)), 5632, 1024, E); } break;
    case 1: case 11: { EpiPlain E; E.O = (bf16_t*)(ws + OFF_XBCP); E.ldc = 1024;
        run_gemm(shm, (const bf16_t*)(ws + OFF_QKV), (const bf16_t*)(ws + OFF_WFOUT + (st == 11 ? SZ_WFOUT : 0)), 1024, 2816, E); } break;
    case 2: ffn_resnorm(p, layer, 1, 0.5f, ng + 2 * DM, probe); break;
    case 3:
        if (hyb) { EpiHyb E; E.ycat = (bf16_t*)(ws + OFF_YCAT); E.xbcp = (bf16_t*)(ws + OFF_XBCP); E.qkv = (bf16_t*)(ws + OFF_QKV); E.misc = (float*)(ws + OFF_MISC);
            run_gemm(shm, (const bf16_t*)(ws + OFF_XN), (const bf16_t*)(ws + OFF_WMIN), 5888, 1024, E); }
        else { EpiRec E; E.G = (bf16_t*)(ws + OFF_YCAT); E.X = (bf16_t*)(ws + OFF_YCAT) + (size_t)MT * 1024;
            run_gemm(shm, (const bf16_t*)(ws + OFF_XN), (const bf16_t*)(ws + OFF_WMIN), 2048, 1024, E); }
        break;
    case 4: if (hyb) hyb_prep_phase(shm, p, mi); else rec_scan_phase(shm, p, mi); break;
    case 5: if (hyb) ssd_states_phase(shm, p); else rec_carry_phase(p); break;
    case 6: if (hyb) ssd_carry_phase(p); else rec_final_phase(p); break;
    case 7: if (hyb) { attn_phase(shm, p); if (!probe) ssd_out_phase(shm, p, mi); } break;
    case 8: { EpiPlain E; E.O = (bf16_t*)(ws + OFF_XBCP); E.ldc = 1024;
        if (hyb) run_gemm(shm, (const bf16_t*)(ws + OFF_YCAT), (const bf16_t*)(ws + OFF_WMOUT), 1024, 2048, E);
        else run_gemm(shm, (const bf16_t*)(ws + OFF_YCAT), (const bf16_t*)(ws + OFF_WMOUT), 1024, 1024, E); } break;
    case 9: ffn_resnorm(p, layer, 3, 1.0f, ng + 4 * DM, probe); break;
    case 12: if (layer < 3 && probe != 2) convert_weights(shm, p, layer + 1);
        if (probe != 1) ffn_resnorm(p, layer, 5, 0.5f, layer < 3 ? p.norm_g + (size_t)(layer + 1) * 6 * DM : nullptr, probe); break;
    }
}
template <int PH> DI void run_all(unsigned char* shm, const Params& p, const XcdBarrier& xbar) {
    if constexpr (PH < NPHASE) {
        constexpr bool skip = PH > 0 && (PH - 1) % STEPS == 7 && ((((PH - 1) / STEPS) & 1) != 0);
        if constexpr (!skip) { run_phase(shm, p, PH, 0); if constexpr (PH + 1 < NPHASE) xcd_barrier(xbar); }
        run_all<PH + 1>(shm, p, xbar);
    }
}
__global__ void __launch_bounds__(NTHR, 2) fwd_megakernel(Params p) {
    extern __shared__ __attribute__((aligned(16))) unsigned char shm[];
    cg::grid_group grid = cg::this_grid();
    if (p.ph_lo < 0) grid.sync();
    volatile LAS unsigned* bst = (volatile LAS unsigned*)(shm + 131072);
    if (tidx() < 4) bst[tidx()] = 0u;
    __syncthreads();
    const XcdBarrier xbar = xcd_barrier_post((unsigned*)(p.ws + OFF_BAR), bst);
#define GSYNC() xcd_barrier(xbar)
#if PROBE_CAT
    unsigned long long tacc_ = 0;
#endif
#if !PROBE_CAT && !REP_MASK && !PER_PHASE_LAUNCH
    run_all<0>(shm, p, xbar);
#else
    for (int ph = p.ph_lo; ph < p.ph_hi; ++ph) {
        if (ph > 0 && (ph - 1) % STEPS == 7 && (((ph - 1) / STEPS) & 1)) continue;
        int nrep = 0;
#if REP_MASK
        { const int layer_ = (ph - 1) / STEPS, st_ = ph ? (ph - 1) % STEPS : -1, hyb_ = (layer_ & 1) == 0;
          const bool isg = st_ == 0 || st_ == 1 || st_ == 3 || st_ == 8 || st_ == 10 || st_ == 11;
          const bool iso = (st_ == 4) || (st_ == 5);
          const bool isa = st_ == 7 && hyb_;
          if (((REP_MASK & 1) && isg) || ((REP_MASK & 4) && iso) || ((REP_MASK & 2) && isa)) nrep = 1;
          if ((REP_MASK & 8) && st_ == 12 && layer_ < 3) nrep = 1;
          if ((REP_MASK & 16) && (st_ == 2 || st_ == 9 || st_ == 12)) nrep = 2;
          if ((REP_MASK & 32) && (st_ == 4 || st_ == 5) && hyb_) nrep = 1;
          if ((REP_MASK & 64) && st_ == 4 && !hyb_) nrep = 1; }
#endif
#if PROBE_CAT
        const unsigned long long t0_ = __builtin_amdgcn_s_memrealtime();
#endif
        for (int r = nrep; r >= 0; r -= (nrep == 2 ? 2 : 1)) { run_phase(shm, p, ph, r);
#if PROBE_CAT == 7
            if (r == 1 && nrep == 1) tacc_ += __builtin_amdgcn_s_memrealtime() - t0_;
#endif
            if (r) GSYNC(); }
#if PROBE_CAT
        { const unsigned long long t1_ = __builtin_amdgcn_s_memrealtime();
          const int layer_ = (ph - 1) / STEPS, st_ = ph ? (ph - 1) % STEPS : -1, hyb_ = (layer_ & 1) == 0; int cat = 0;
          if (st_ == 0 || st_ == 1 || st_ == 3 || st_ == 8 || st_ == 10 || st_ == 11) cat = 1;
          else if (ph == 0 || st_ == 2 || st_ == 9 || st_ == 12) cat = 2;
          else if (st_ == 7) cat = 3;
          else cat = hyb_ ? 4 : 5;
          if (cat == PROBE_CAT) tacc_ += t1_ - t0_;
          if (ph + 1 < p.ph_hi) GSYNC();
          if (PROBE_CAT == 6) tacc_ += __builtin_amdgcn_s_memrealtime() - t1_;
          continue; }
#endif
        if (ph + 1 < p.ph_hi) GSYNC();
    }
#endif
#if PROBE_CAT
    if (bidx() == 0) { const unsigned long long te_ = __builtin_amdgcn_s_memrealtime(); while (__builtin_amdgcn_s_memrealtime() - te_ < 4ull * tacc_) __builtin_amdgcn_s_sleep(8); }
#endif
}

extern "C" void kernel_launch(void* const* d_in, const int* in_sizes, int n_in, void* d_out, int out_size, void* d_ws, size_t ws_size, hipStream_t stream) {
    static int grid = 0;
    if (grid == 0) {
        if (n_in != 22 || out_size != MT * DM || ws_size < WS_END) { fprintf(stderr, "kernel_launch: unexpected shapes (n_in %d out %d ws %zu need %zu)\n", n_in, out_size, ws_size, (size_t)WS_END); grid = -1; return; }
        int dev = 0, cus = 0, per_cu = 0;
        hipGetDevice(&dev); hipDeviceGetAttribute(&cus, hipDeviceAttributeMultiprocessorCount, dev);
        if (hipFuncSetAttribute((const void*)fwd_megakernel, hipFuncAttributeMaxDynamicSharedMemorySize, LDS_TOTAL) != hipSuccess) { fprintf(stderr, "kernel_launch: hipFuncSetAttribute failed\n"); grid = -1; return; }
        if (hipOccupancyMaxActiveBlocksPerMultiprocessor(&per_cu, (const void*)fwd_megakernel, NTHR, LDS_TOTAL) != hipSuccess || per_cu < 1) { fprintf(stderr, "kernel_launch: occupancy query says %d\n", per_cu); per_cu = 1; }
        (void)hipGetLastError();
        grid = cus * (per_cu > 1 ? 1 : per_cu);
        if (grid <= 0) grid = 256;
    }
    if (grid < 0) return;
    Params p{};
    const float** f = (const float**)&p;
    for (int i = 0; i < 22; ++i) f[i] = (const float*)d_in[i];
    p.out = (float*)d_out; p.ws = (unsigned char*)d_ws;
#if PER_PHASE_LAUNCH
    for (int ph = 0; ph < NPHASE; ++ph) { p.ph_lo = ph; p.ph_hi = ph + 1;
        hipLaunchKernelGGL(fwd_megakernel, dim3(grid), dim3(NTHR), LDS_TOTAL, stream, p); }
#else
    p.ph_lo = 0; p.ph_hi = NPHASE;
    if (hipMemsetAsync((unsigned char*)d_ws + OFF_BAR, 0, 16384, stream) != hipSuccess) { fprintf(stderr, "kernel_launch: memset failed\n"); return; }
    void* args[] = {&p};
    hipError_t e = hipLaunchCooperativeKernel((const void*)fwd_megakernel, dim3(grid), dim3(NTHR), args, LDS_TOTAL, stream);
    if (e != hipSuccess) fprintf(stderr, "cooperative launch failed: %s (grid %d)\n", hipGetErrorString(e), grid);
#endif
}
```
